# Optimizing an MI355X kernel written in HIP

```python
import math
import jax, jax.numpy as jnp
from jax import lax
import numpy as np

D_MODEL = 2048
BATCH = 8
SEQ = 4096
DEPTH = 1

HEAD_DIM = 128
CONV_WIDTH = D_MODEL // 2
CONV_GROUPS = CONV_WIDTH // HEAD_DIM
DIL_PAIRS = ((128, 1), (512, 4), (2048, 16))
N_DIL = len(DIL_PAIRS)
HEADS_PER_DIL = (D_MODEL // 2) // HEAD_DIM
N_PAT_HEADS = N_DIL * HEADS_PER_DIL
ATTN_OUT_WIDTH = HEADS_PER_DIL * HEAD_DIM
MIX_WIDTH = CONV_WIDTH + ATTN_OUT_WIDTH
QKV_WIDTH = N_PAT_HEADS * HEAD_DIM
PROJ_WIDTH = 3 * CONV_WIDTH + 3 * QKV_WIDTH
SPLITS = [CONV_WIDTH, 2 * CONV_WIDTH, 3 * CONV_WIDTH,
          3 * CONV_WIDTH + QKV_WIDTH, 3 * CONV_WIDTH + 2 * QKV_WIDTH]
D_FF = 256 * (-(-(8 * D_MODEL) // (3 * 256)))
N_BUCKETS = 32
MAX_DISTANCE = 2048
BLK = 128
LN_EPS = 1e-5
ALPHA = (2 * DEPTH) ** 0.25
BETA = (8 * DEPTH) ** -0.25

kernel_name = "hybrid_conv_dilated_attn_deepnorm_layer"


def _layernorm(x, g, b):
    xf = x.astype(jnp.float32)
    mu = jnp.mean(xf, axis=-1, keepdims=True)
    var = jnp.mean(jnp.square(xf - mu), axis=-1, keepdims=True)
    return ((xf - mu) * lax.rsqrt(var + LN_EPS) * g.astype(jnp.float32) + b.astype(jnp.float32)).astype(x.dtype)


def _causal_conv3(x, w):
    xp = jnp.pad(x, ((0, 0), (2, 0), (0, 0)))
    return w[0] * xp[:, :-2] + w[1] * xp[:, 1:-1] + w[2] * xp[:, 2:]


def _t5_bucket(dist):
    max_exact = N_BUCKETS // 2
    n = np.maximum(dist, 1).astype(np.float32)
    large = max_exact + (np.log(n / max_exact) / math.log(MAX_DISTANCE / max_exact)
                         * (N_BUCKETS - max_exact)).astype(np.int32)
    large = np.minimum(large, N_BUCKETS - 1)
    return np.where(dist < max_exact, dist, large).astype(np.int32)


def _dilated_window_attention(q, k, v, bias_table, window, dilation):
    b, s, h, dh = q.shape
    n_steps = window // dilation
    L = s // dilation
    nb = -(-L // BLK)
    lp = nb * BLK

    def to_blocks(t):
        t = t.reshape(b, L, dilation, h, dh).transpose(0, 2, 3, 1, 4)
        t = jnp.pad(t, ((0, 0), (0, 0), (0, 0), (0, lp - L), (0, 0)))
        return t.reshape(b, dilation, h, nb, BLK, dh)

    def with_prev(t):
        prev = jnp.pad(t, ((0, 0), (0, 0), (0, 0), (1, 0), (0, 0), (0, 0)))[:, :, :, :-1]
        return jnp.concatenate([prev, t], axis=4)

    qb = to_blocks(q)
    kk = with_prev(to_blocks(k))
    vv = with_prev(to_blocks(v))

    qi = np.arange(BLK)[:, None]
    ki = np.arange(2 * BLK)[None, :]
    steps = qi + BLK - ki
    in_window = (steps >= 0) & (steps <= n_steps)
    bucket = _t5_bucket(np.clip(steps, 0, None) * dilation)
    bias = jnp.take(bias_table, jnp.asarray(bucket), axis=0)
    bias = bias.transpose(2, 0, 1).astype(jnp.float32)
    key_exists = (np.arange(nb)[:, None, None] * BLK - BLK + ki[None]) >= 0
    valid = jnp.asarray(in_window[None] & key_exists)

    scores = jnp.einsum('bdhnqc,bdhnkc->bdhnqk', qb, kk).astype(jnp.float32) * (dh ** -0.5)
    scores = scores + bias[:, None]
    scores = jnp.where(valid, scores, jnp.finfo(jnp.float32).min)
    m = jnp.max(scores, axis=-1, keepdims=True)
    p = jnp.exp(scores - m)
    denom = jnp.sum(p, axis=-1, keepdims=True)
    o = jnp.einsum('bdhnqk,bdhnkc->bdhnqc', p, vv.astype(jnp.float32)) / denom
    lse = (m + jnp.log(denom))

    def from_blocks(t):
        t = t.reshape(b, dilation, h, lp, t.shape[-1])[:, :, :, :L]
        return t.transpose(0, 3, 1, 2, 4).reshape(b, s, h, t.shape[-1])

    return from_blocks(o), from_blocks(lse)[..., 0]


def _token_mixer(x, w_in, conv_w, w_out, rel_bias):
    b, s, _ = x.shape
    proj = x @ w_in
    u, gate_b, gate_c, q, k, v = jnp.split(proj, SPLITS, axis=-1)
    y_conv = gate_b * _causal_conv3(gate_c * u, conv_w)
    q = q.reshape(b, s, N_DIL, HEADS_PER_DIL, HEAD_DIM)
    k = k.reshape(b, s, N_DIL, HEADS_PER_DIL, HEAD_DIM)
    v = v.reshape(b, s, N_DIL, HEADS_PER_DIL, HEAD_DIM)
    outs, lses = [], []
    for g, (window, dilation) in enumerate(DIL_PAIRS):
        o_g, lse_g = _dilated_window_attention(
            q[:, :, g], k[:, :, g], v[:, :, g],
            rel_bias[:, g * HEADS_PER_DIL:(g + 1) * HEADS_PER_DIL], window, dilation)
        outs.append(o_g)
        lses.append(lse_g)
    o_all = jnp.stack(outs, axis=0)
    wts = jax.nn.softmax(jnp.stack(lses, axis=0), axis=0)
    y_attn = jnp.sum(wts[..., None] * o_all, axis=0).reshape(b, s, ATTN_OUT_WIDTH).astype(x.dtype)
    return jnp.concatenate([y_conv, y_attn], axis=-1) @ w_out


def _conv_ffn(h, w_up, conv_w, conv_b, w_down):
    up = _causal_conv3(h @ w_up, conv_w) + conv_b
    a, g = jnp.split(up, 2, axis=-1)
    return (jax.nn.silu(g) * a) @ w_down


def setup_inputs(seed: int = 0) -> dict:
    key = jax.random.key(seed)
    ks = jax.random.split(key, 13)
    f32 = jnp.float32
    col_scale = jnp.concatenate([
        jnp.full((CONV_WIDTH,), BETA, f32),
        jnp.ones((2 * CONV_WIDTH + 2 * QKV_WIDTH,), f32),
        jnp.full((QKV_WIDTH,), BETA, f32)])
    return {
        "x": jax.random.normal(ks[0], (BATCH, SEQ, D_MODEL), f32),
        "w_in": jax.random.normal(ks[1], (DEPTH, D_MODEL, PROJ_WIDTH), f32) * (D_MODEL ** -0.5) * col_scale,
        "conv_mix_w": jax.random.normal(ks[2], (DEPTH, 3, CONV_WIDTH), f32) * (3 ** -0.5),
        "w_out": jax.random.normal(ks[3], (DEPTH, MIX_WIDTH, D_MODEL), f32) * (MIX_WIDTH ** -0.5) * BETA,
        "ln1_g": 1.0 + 0.02 * jax.random.normal(ks[4], (DEPTH, D_MODEL), f32),
        "ln1_b": 0.02 * jax.random.normal(ks[5], (DEPTH, D_MODEL), f32),
        "w_up": jax.random.normal(ks[6], (DEPTH, D_MODEL, 2 * D_FF), f32) * (D_MODEL ** -0.5) * BETA,
        "ffn_conv_w": jax.random.normal(ks[7], (DEPTH, 3, 2 * D_FF), f32) * (3 ** -0.5),
        "ffn_conv_b": 0.02 * jax.random.normal(ks[8], (DEPTH, 2 * D_FF), f32),
        "w_down": jax.random.normal(ks[9], (DEPTH, D_FF, D_MODEL), f32) * (D_FF ** -0.5) * BETA,
        "ln2_g": 1.0 + 0.02 * jax.random.normal(ks[10], (DEPTH, D_MODEL), f32),
        "ln2_b": 0.02 * jax.random.normal(ks[11], (DEPTH, D_MODEL), f32),
        "rel_bias": 0.2 * jax.random.normal(ks[12], (N_BUCKETS, N_PAT_HEADS), f32),
    }


def reference(x, w_in, conv_mix_w, w_out, ln1_g, ln1_b, w_up, ffn_conv_w, ffn_conv_b,
              w_down, ln2_g, ln2_b, rel_bias):
    for layer in range(DEPTH):
        mix = _token_mixer(x, w_in[layer], conv_mix_w[layer], w_out[layer], rel_bias)
        x = _layernorm(ALPHA * x + mix, ln1_g[layer], ln1_b[layer])
        ffn = _conv_ffn(x, w_up[layer], ffn_conv_w[layer], ffn_conv_b[layer], w_down[layer])
        x = _layernorm(ALPHA * x + ffn, ln2_g[layer], ln2_b[layer])
    return x
```

```cpp
#include <hip/hip_runtime.h>
#include <hip/hip_cooperative_groups.h>
#include <cstdio>
#include <cstdint>
namespace cg = cooperative_groups;
namespace pg8 {
#define PG8_LAS __attribute__((address_space(3)))
typedef unsigned short bf16_t;
typedef short bf16x8 __attribute__((ext_vector_type(8)));
typedef float f32x4 __attribute__((ext_vector_type(4)));
typedef unsigned u32x4 __attribute__((ext_vector_type(4)));
typedef unsigned u32x2 __attribute__((ext_vector_type(2)));
constexpr int BM = 256, BK = 64, HALF = 128, HTB = HALF * BK * 2  , STAGE_BYTES = 8 * HTB, NXCD = 8, WGM = 8;

__host__ __device__ __forceinline__ int lds_byte(int r, int c) { const int st = (r >> 4) * 2 + (c >> 5), rr = r & 15, cc = c & 31, ob = rr * 64 + cc * 2; return st * 1024 + (ob ^ (((ob >> 9) & 1) << 5)); }
__host__ __device__ __forceinline__ void stage_rc(int b, int& R, int& C) { const int st = b / 1024, sb = b % 1024, swz = sb ^ (((sb >> 9) & 1) << 5); R = (st >> 1) * 16 + swz / 64; C = (st & 1) * 32 + (swz % 64) / 2; }
__host__ __device__ __forceinline__ int perm32(int rho) { const int n = rho >> 4, i = rho & 15; return 8 * (i >> 2) + 4 * n + (i & 3); }

struct Unit { int pm, pn; };
struct Gemm { const bf16_t* A; const bf16_t* Bt; int M, N, K; };

struct StaticOrder {
    int nM, nN, nwg, G, c;
    __host__ __device__ void init(int M, int N, int G_, int c_) { nM = M / BM; nN = N / BM; nwg = nM * nN; G = G_; c = c_; }
    __host__ __device__ bool next(int i, Unit& u) const {
        const long L = (long)i * G + c; if (L >= nwg) return false;
        int wgid = (int)L; { const int q = nwg / NXCD, r = nwg % NXCD, xcd = wgid % NXCD, off = wgid / NXCD; wgid = (xcd < r ? xcd * (q + 1) : r * (q + 1) + (xcd - r) * q) + off; }
        const int nig = WGM * nN, gid = wgid / nig, fm = gid * WGM, gsz = (nM - fm) < WGM ? (nM - fm) : WGM;
        u.pm = fm + ((wgid % nig) % gsz); u.pn = (wgid % nig) / gsz; return true;
    }
    __device__ __forceinline__ void a_ready(const Unit&) const {}
    __device__ __forceinline__ void done(const Unit&) const {}
};

__device__ __forceinline__ unsigned cvt_pk_bf16(float lo, float hi) { unsigned r; asm volatile("v_cvt_pk_bf16_f32 %0, %1, %2" : "=v"(r) : "v"(lo), "v"(hi)); return r; }
struct EpiBf16 {
    static constexpr bool PERM = true, AFTER_DRAIN = false;
    bf16_t* O; int ldc;
    __device__ __forceinline__ void operator()(const f32x4 (&acc)[2][2][4][2], const Unit& u, int wr, int wc, int fr, int fq) const {
        const int row0 = u.pm * BM + wr * 64 + fr; const int col0 = u.pn * BM + wc * 32 + 8 * fq;
#pragma unroll
        for (int ai = 0; ai < 2; ++ai)
#pragma unroll
            for (int m = 0; m < 4; ++m) { bf16_t* rowp = O + (size_t)(row0 + ai * HALF + m * 16) * ldc + col0;
#pragma unroll
                for (int bj = 0; bj < 2; ++bj) { const f32x4 v0 = acc[ai][bj][m][0], v1 = acc[ai][bj][m][1];
                    u32x4 w; w.x = cvt_pk_bf16(v0[0], v0[1]); w.y = cvt_pk_bf16(v0[2], v0[3]); w.z = cvt_pk_bf16(v1[0], v1[1]); w.w = cvt_pk_bf16(v1[2], v1[3]);
                    *(u32x4*)(rowp + bj * HALF) = w; } }
    }
};
struct EpiResF32 {
    static constexpr bool PERM = true, AFTER_DRAIN = false;
    const float* base; float* out; int ldc; float alpha;
    __device__ __forceinline__ void operator()(const f32x4 (&acc)[2][2][4][2], const Unit& u, int wr, int wc, int fr, int fq) const {
        const int row0 = u.pm * BM + wr * 64 + fr; const int col0 = u.pn * BM + wc * 32 + 8 * fq;
#pragma unroll
        for (int ai = 0; ai < 2; ++ai)
#pragma unroll
            for (int m = 0; m < 4; ++m) { const size_t off = (size_t)(row0 + ai * HALF + m * 16) * ldc + col0;
#pragma unroll
                for (int bj = 0; bj < 2; ++bj) {
                    const f32x4 b0 = *(const f32x4*)(base + off + bj * HALF), b1 = *(const f32x4*)(base + off + bj * HALF + 4);
                    *(f32x4*)(out + off + bj * HALF) = b0 * alpha + acc[ai][bj][m][0];
                    *(f32x4*)(out + off + bj * HALF + 4) = b1 * alpha + acc[ai][bj][m][1]; }
                if (m & 1) asm volatile("" ::: "memory"); }
    }
};


template <int CTRL> __device__ __forceinline__ float dppf(float old, float src) {
    return __builtin_bit_cast(float, __builtin_amdgcn_update_dpp(__builtin_bit_cast(int, old), __builtin_bit_cast(int, src), CTRL, 0xf, 0xf, false)); }
struct EpiFfn {
    static constexpr bool PERM = true, AFTER_DRAIN = false;
    bf16_t* act; float* raw; const float* cw; const float* cb; PG8_LAS float* xch; int dff;
    __device__ __forceinline__ void operator()(const f32x4 (&acc)[2][2][4][2], const Unit& u, int wr, int wc, int fr, int fq) const {
        const int upw = 2 * dff;
        if (fr >= 14) {
#pragma unroll
            for (int ai = 0; ai < 2; ++ai)
#pragma unroll
                for (int bj = 0; bj < 2; ++bj)
#pragma unroll
                    for (int n = 0; n < 2; ++n) *(PG8_LAS f32x4*)(xch + ((ai * 2 + wr) * 4 + wc) * 128 + (fr - 14) * 64 + (bj * 2 + n) * 16 + fq * 4) = acc[ai][bj][3][n];
            if (wr == 1) {
#pragma unroll
                for (int bj = 0; bj < 2; ++bj)
#pragma unroll
                    for (int n = 0; n < 2; ++n) *(f32x4*)(raw + ((size_t)u.pm * 4 + 2 + (fr - 14)) * upw + u.pn * BM + bj * HALF + wc * 32 + 8 * fq + 4 * n) = acc[1][bj][3][n];
            }
        }
        if (fr < 2 && wr == 0) {
#pragma unroll
            for (int bj = 0; bj < 2; ++bj)
#pragma unroll
                for (int n = 0; n < 2; ++n) *(f32x4*)(raw + ((size_t)u.pm * 4 + fr) * upw + u.pn * BM + bj * HALF + wc * 32 + 8 * fq + 4 * n) = acc[0][bj][0][n];
        }
        asm volatile("s_waitcnt lgkmcnt(0)" ::: "memory"); __builtin_amdgcn_s_barrier(); asm volatile("" ::: "memory");
        u32x2 keep[2][4];
#pragma unroll
        for (int n = 0; n < 2; ++n) {
            const int ch0 = u.pn * HALF + wc * 32 + 8 * fq + 4 * n;
            f32x4 w0[2], w1[2], w2[2], bb[2];
#pragma unroll
            for (int bj = 0; bj < 2; ++bj) { w0[bj] = *(const f32x4*)(cw + bj * dff + ch0); w1[bj] = *(const f32x4*)(cw + upw + bj * dff + ch0); w2[bj] = *(const f32x4*)(cw + 2 * upw + bj * dff + ch0); bb[bj] = *(const f32x4*)(cb + bj * dff + ch0); }
#pragma unroll
            for (int ai = 0; ai < 2; ++ai) {
                f32x4 h15[2], h14[2];
                if (wr == 1 || ai == 1) { const int src = (wr == 1) ? (ai * 2 + 0) : (0 * 2 + 1);
#pragma unroll
                    for (int bj = 0; bj < 2; ++bj) { h14[bj] = *(const PG8_LAS f32x4*)(xch + (src * 4 + wc) * 128 + 0 * 64 + (bj * 2 + n) * 16 + fq * 4); h15[bj] = *(const PG8_LAS f32x4*)(xch + (src * 4 + wc) * 128 + 1 * 64 + (bj * 2 + n) * 16 + fq * 4); }
                } else {
#pragma unroll
                    for (int bj = 0; bj < 2; ++bj) { h14[bj] = (f32x4){0.f, 0.f, 0.f, 0.f}; h15[bj] = (f32x4){0.f, 0.f, 0.f, 0.f}; } }
#pragma unroll
                for (int m = 0; m < 4; ++m) {
                    float val[2][4];
#pragma unroll
                    for (int bj = 0; bj < 2; ++bj)
#pragma unroll
                        for (int jj = 0; jj < 4; ++jj) {
                            const float cur = acc[ai][bj][m][n][jj];
                            float o1, o2;
                            if (m > 0) { const float pv = acc[ai][bj][m > 0 ? m - 1 : 0][n][jj]; o1 = dppf<0x121>(0.f, pv); o2 = dppf<0x122>(0.f, pv); }
                            else { o1 = h15[bj][jj]; o2 = (fr == 0) ? h14[bj][jj] : h15[bj][jj]; }
                            const float p1 = dppf<0x111>(o1, cur), p2 = dppf<0x112>(o2, cur);
                            val[bj][jj] = w2[bj][jj] * cur + w1[bj][jj] * p1 + w0[bj][jj] * p2 + bb[bj][jj];
                        }
                    float y[4];
#pragma unroll
                    for (int jj = 0; jj < 4; ++jj) { const float g = val[1][jj]; y[jj] = val[0][jj] * g * __builtin_amdgcn_rcpf(1.0f + __builtin_amdgcn_exp2f(-1.4426950408889634f * g)); }
                    u32x2 w; w.x = cvt_pk_bf16(y[0], y[1]); w.y = cvt_pk_bf16(y[2], y[3]);
                    if (n == 0) keep[ai][m] = w;
                    else { const int row = u.pm * BM + ai * HALF + wr * 64 + m * 16 + fr;
                        u32x4 w4; w4.x = keep[ai][m].x; w4.y = keep[ai][m].y; w4.z = w.x; w4.w = w.y;
                        *(u32x4*)(act + (size_t)row * dff + ch0 - 4) = w4; }
                }
            }
        }
    }
};


struct EpiProj {
    static constexpr bool PERM = true, AFTER_DRAIN = false;
    bf16_t* O; int ldc; bf16_t* ymix; float* rawc; float* rawb; const float* cw; PG8_LAS float* xch;
    __device__ __forceinline__ void operator()(const f32x4 (&acc)[2][2][4][2], const Unit& u, int wr, int wc, int fr, int fq) const {
        const int bb = u.pm >> 4, tb0 = (u.pm & 15) * BM + wr * 64 + fr;
        if (u.pn >= 16) {
#pragma unroll
            for (int bj = 0; bj < 2; ++bj) {
                const int hh = 2 * u.pn + bj - 24, ty = hh / 24, g = (hh % 24) >> 3, h = hh & 7;
                bf16_t* plane = O + ((size_t)(((ty * 3 + g) * 8 + bb) * 8 + h) << 19) + wc * 32 + 8 * fq;
#pragma unroll
                for (int ai = 0; ai < 2; ++ai)
#pragma unroll
                    for (int m = 0; m < 4; ++m) { const int t = tb0 + ai * HALF + m * 16; const int ridx = ((t & ((1 << (2 * g)) - 1)) << (12 - 2 * g)) + (t >> (2 * g));
                        const f32x4 v0 = acc[ai][bj][m][0], v1 = acc[ai][bj][m][1];
                        u32x4 w; w.x = cvt_pk_bf16(v0[0], v0[1]); w.y = cvt_pk_bf16(v0[2], v0[3]); w.z = cvt_pk_bf16(v1[0], v1[1]); w.w = cvt_pk_bf16(v1[2], v1[3]);
                        *(u32x4*)(plane + (size_t)ridx * 128) = w; }
            }
            return;
        }
        const int ch0 = u.pn * 64 + wc * 16 + fq * 4;
        if (fr >= 14) {
#pragma unroll
            for (int ai = 0; ai < 2; ++ai) *(PG8_LAS f32x4*)(xch + ((ai * 2 + wr) * 4 + wc) * 32 + (fr - 14) * 16 + fq * 4) = acc[ai][0][3][0] * acc[ai][0][3][1];
            if (wr == 1) *(f32x4*)(rawc + ((size_t)u.pm * 4 + 2 + (fr - 14)) * 1024 + ch0) = acc[1][0][3][0] * acc[1][0][3][1];
        }
        if (fr < 2 && wr == 0) { *(f32x4*)(rawc + ((size_t)u.pm * 4 + fr) * 1024 + ch0) = acc[0][0][0][0] * acc[0][0][0][1]; *(f32x4*)(rawb + ((size_t)u.pm * 2 + fr) * 1024 + ch0) = acc[0][1][0][0]; }
        asm volatile("s_waitcnt lgkmcnt(0)" ::: "memory"); __builtin_amdgcn_s_barrier(); asm volatile("" ::: "memory");
        const f32x4 w0 = *(const f32x4*)(cw + ch0), w1 = *(const f32x4*)(cw + 1024 + ch0), w2 = *(const f32x4*)(cw + 2048 + ch0);
#pragma unroll
        for (int ai = 0; ai < 2; ++ai) {
            f32x4 h15, h14;
            if (wr == 1 || ai == 1) { const int src = (wr == 1) ? (ai * 2 + 0) : (0 * 2 + 1);
                h14 = *(const PG8_LAS f32x4*)(xch + (src * 4 + wc) * 32 + 0 * 16 + fq * 4); h15 = *(const PG8_LAS f32x4*)(xch + (src * 4 + wc) * 32 + 1 * 16 + fq * 4);
            } else { h14 = (f32x4){0.f, 0.f, 0.f, 0.f}; h15 = (f32x4){0.f, 0.f, 0.f, 0.f}; }
            f32x4 prev = (f32x4){0.f, 0.f, 0.f, 0.f};
#pragma unroll
            for (int m = 0; m < 4; ++m) {
                const f32x4 cur = acc[ai][0][m][0] * acc[ai][0][m][1];
                f32x4 y;
#pragma unroll
                for (int jj = 0; jj < 4; ++jj) {
                    float o1, o2;
                    if (m > 0) { o1 = dppf<0x121>(0.f, prev[jj]); o2 = dppf<0x122>(0.f, prev[jj]); }
                    else { o1 = h15[jj]; o2 = (fr == 0) ? h14[jj] : h15[jj]; }
                    const float p1 = dppf<0x111>(o1, cur[jj]), p2 = dppf<0x112>(o2, cur[jj]);
                    y[jj] = acc[ai][1][m][0][jj] * (w2[jj] * cur[jj] + w1[jj] * p1 + w0[jj] * p2);
                }
                prev = cur;
                const size_t row = (size_t)(u.pm * BM + ai * HALF + wr * 64 + m * 16 + fr);
                u32x2 wy; wy.x = cvt_pk_bf16(y[0], y[1]); wy.y = cvt_pk_bf16(y[2], y[3]);
                const f32x4 q = acc[ai][1][m][1];
                u32x2 wq; wq.x = cvt_pk_bf16(q[0], q[1]); wq.y = cvt_pk_bf16(q[2], q[3]);
                const auto s0 = __builtin_amdgcn_permlane16_swap(wy.x, wq.x, false, false); const auto s1 = __builtin_amdgcn_permlane16_swap(wy.y, wq.y, false, false);
                u32x4 w4; w4.x = s0[0]; w4.y = s1[0]; w4.z = s0[1]; w4.w = s1[1];
                bf16_t* dy = ymix + row * 2048 + ch0;
                bf16_t* dq = O + ((size_t)(bb * 8 + (ch0 >> 7)) << 19) + (size_t)(tb0 + ai * HALF + m * 16) * 128 + ((ch0 - 4) & 127);
                *(u32x4*)((fq & 1) ? dq : dy) = w4;
            }
        }
    }
};

template <class Epi, class Sched, bool ALIGN_EPI = false, bool SP2 = false>
__device__ __forceinline__ void gemm_phase(PG8_LAS unsigned char* lds, const Gemm g, const Sched& S, const Epi& E) {
    int tid_l = threadIdx.x; asm volatile("" : "+v"(tid_l));
    const int tid = tid_l, wid = __builtin_amdgcn_readfirstlane(tid >> 6), lane = tid & 63, wr = wid >> 2, wc = wid & 3, fr = lane & 15, fq = lane >> 4;
    const int K = g.K, nt = K / BK;
    unsigned voffA[2], voffB[2];
#pragma unroll
    for (int i = 0; i < 2; ++i) { int R, C; stage_rc(tid * 16 + i * 8192, R, C); const int Rb = Epi::PERM ? ((R & ~31) + perm32(R & 31)) : R;
        voffA[i] = (unsigned)(R * K + C) * 2u; voffB[i] = (unsigned)(Rb * K + C) * 2u; }
    const size_t kstep = (size_t)(BK * 2);
    const size_t hstep = (size_t)HALF * K * 2;
    const size_t tstep = 2 * hstep;
    const unsigned ldsw = (unsigned)wid * 1024u;
    const int aoff = lds_byte(wr * 64 + fr, fq * 8), boff = lds_byte(wc * 32 + fr, fq * 8);
#define PG8_SA(b, h) (((b) * 2 + (h)) * HTB)
#define PG8_SB(b, h) ((4 + (b) * 2 + (h)) * HTB)
#define PG8_STAGE(bufoff, gbase, voff) do { _Pragma("unroll") for (int _i = 0; _i < 2; ++_i) \
        __builtin_amdgcn_global_load_lds((const unsigned*)((const char*)(gbase) + (voff)[_i]), (PG8_LAS unsigned*)(lds + (bufoff) + ldsw + _i * 8192), 16, 0, 0); } while (0)
#define PG8_LDA(dst, b, h) do { _Pragma("unroll") for (int m = 0; m < 4; ++m) _Pragma("unroll") for (int k = 0; k < 2; ++k) dst[m][k] = *(const PG8_LAS bf16x8*)(lds + PG8_SA(b, h) + aoff + m * 2048 + k * 1024); } while (0)
#define PG8_LDB(dst, b, h) do { _Pragma("unroll") for (int n = 0; n < 2; ++n) _Pragma("unroll") for (int k = 0; k < 2; ++k) dst[n][k] = *(const PG8_LAS bf16x8*)(lds + PG8_SB(b, h) + boff + n * 2048 + k * 1024); } while (0)
#define PG8_MMA(ai, bj, At, Bt) do { __builtin_amdgcn_s_setprio(1); _Pragma("unroll") for (int m = 0; m < 4; ++m) _Pragma("unroll") for (int n = 0; n < 2; ++n) _Pragma("unroll") for (int k = 0; k < 2; ++k) \
        acc[ai][bj][m][n] = __builtin_amdgcn_mfma_f32_16x16x32_bf16(Bt[n][k], At[m][k], acc[ai][bj][m][n], 0, 0, 0); __builtin_amdgcn_s_setprio(0); } while (0)
#define PG8_WAIT_V(n) asm volatile("s_waitcnt vmcnt(" #n ")" ::: "memory")
#define PG8_WAIT_L(n) asm volatile("s_waitcnt lgkmcnt(" #n ")" ::: "memory")
#define PG8_BAR __builtin_amdgcn_s_barrier()
#define PG8_SCHED __builtin_amdgcn_sched_barrier(0)
    Unit cur, nxt; int ui = 0;
    if (!S.next(0, cur)) return;
    f32x4 acc[2][2][4][2];
#pragma unroll
    for (int a = 0; a < 2; ++a)
#pragma unroll
        for (int b = 0; b < 2; ++b)
#pragma unroll
            for (int m = 0; m < 4; ++m)
#pragma unroll
                for (int n = 0; n < 2; ++n) acc[a][b][m][n] = (f32x4){0.f, 0.f, 0.f, 0.f};
    bf16x8 At[4][2], B0[2][2], B1[2][2];
    const char* cA = (const char*)g.A + (size_t)cur.pm * tstep; const char* cB = (const char*)g.Bt + (size_t)cur.pn * tstep;
    S.a_ready(cur);
    if constexpr (SP2) {
        PG8_STAGE(PG8_SB(0, 0), cB, voffB); PG8_STAGE(PG8_SB(0, 1), cB + hstep, voffB); PG8_STAGE(PG8_SA(0, 0), cA, voffA); PG8_STAGE(PG8_SA(0, 1), cA + hstep, voffA);
        if (wr == 1) PG8_BAR;
        PG8_WAIT_V(2); PG8_BAR;
        PG8_STAGE(PG8_SB(1, 0), cB + kstep, voffB); PG8_STAGE(PG8_SA(1, 0), cA + kstep, voffA); PG8_STAGE(PG8_SB(1, 1), cB + hstep + kstep, voffB);
        PG8_WAIT_V(6); PG8_BAR;
    } else {
        PG8_STAGE(PG8_SB(0, 0), cB, voffB); PG8_STAGE(PG8_SA(0, 0), cA, voffA); PG8_STAGE(PG8_SB(0, 1), cB + hstep, voffB); PG8_STAGE(PG8_SA(0, 1), cA + hstep, voffA);
        if (wr == 1) PG8_BAR;
        PG8_WAIT_V(4); PG8_BAR;
        PG8_STAGE(PG8_SB(1, 0), cB + kstep, voffB); PG8_STAGE(PG8_SA(1, 0), cA + kstep, voffA); PG8_STAGE(PG8_SB(1, 1), cB + hstep + kstep, voffB);
        PG8_WAIT_V(6); PG8_BAR;
    }
    for (;;) {
        const bool has_next = S.next(ui + 1, nxt);
        const char* nA = has_next ? (const char*)g.A + (size_t)nxt.pm * tstep : cA; const char* nB = has_next ? (const char*)g.Bt + (size_t)nxt.pn * tstep : cB;
        for (int t = 0; t < nt; t += 2) {
            const bool last = (t == nt - 2);
            const char* a1 = cA + (size_t)(t + 1) * kstep;
            const char* a2 = last ? nA : cA + (size_t)(t + 2) * kstep; const char* b2 = last ? nB : cB + (size_t)(t + 2) * kstep;
            const char* a3 = a2 + kstep; const char* b3 = b2 + kstep;
            if (last && has_next) S.a_ready(nxt);
            if constexpr (SP2) {
            PG8_LDB(B0, 0, 0); PG8_LDB(B1, 0, 1); PG8_SCHED; PG8_LDA(At, 0, 0); PG8_STAGE(PG8_SA(1, 1), a1 + hstep, voffA);
            PG8_WAIT_V(8); PG8_WAIT_L(0); PG8_BAR; PG8_MMA(0, 0, At, B0); PG8_MMA(0, 1, At, B1); PG8_BAR; PG8_SCHED;
            PG8_LDA(At, 0, 1); PG8_STAGE(PG8_SB(0, 0), b2, voffB); PG8_STAGE(PG8_SB(0, 1), b2 + hstep, voffB); PG8_STAGE(PG8_SA(0, 0), a2, voffA);
            PG8_WAIT_V(8); PG8_WAIT_L(0); PG8_BAR; PG8_MMA(1, 0, At, B0); PG8_MMA(1, 1, At, B1); PG8_BAR; PG8_SCHED;
            PG8_LDB(B0, 1, 0); PG8_LDB(B1, 1, 1); PG8_SCHED; PG8_LDA(At, 1, 0); PG8_STAGE(PG8_SA(0, 1), a2 + hstep, voffA);
            PG8_WAIT_V(8); PG8_WAIT_L(0); PG8_BAR; PG8_MMA(0, 0, At, B0); PG8_MMA(0, 1, At, B1); PG8_BAR; PG8_SCHED;
            PG8_LDA(At, 1, 1); PG8_STAGE(PG8_SB(1, 0), b3, voffB); PG8_STAGE(PG8_SB(1, 1), b3 + hstep, voffB); PG8_STAGE(PG8_SA(1, 0), a3, voffA);
            PG8_WAIT_V(8); PG8_WAIT_L(0); PG8_BAR; PG8_MMA(1, 0, At, B0); PG8_MMA(1, 1, At, B1); PG8_BAR; PG8_SCHED;
            } else {
            PG8_LDB(B0, 0, 0); PG8_SCHED; PG8_LDA(At, 0, 0); PG8_STAGE(PG8_SA(1, 1), a1 + hstep, voffA);
            PG8_WAIT_L(8); PG8_BAR; PG8_WAIT_L(0); PG8_MMA(0, 0, At, B0); PG8_BAR; PG8_SCHED;
            PG8_LDB(B1, 0, 1); PG8_STAGE(PG8_SB(0, 0), b2, voffB);
            PG8_BAR; PG8_WAIT_L(0); PG8_MMA(0, 1, At, B1); PG8_BAR;
            PG8_LDA(At, 0, 1); PG8_STAGE(PG8_SA(0, 0), a2, voffA);
            PG8_BAR; PG8_WAIT_L(0); PG8_MMA(1, 0, At, B0); PG8_BAR; PG8_SCHED;
            PG8_STAGE(PG8_SB(0, 1), b2 + hstep, voffB);
            PG8_WAIT_V(6); PG8_BAR; PG8_MMA(1, 1, At, B1); PG8_BAR;
            PG8_LDB(B0, 1, 0); PG8_SCHED; PG8_LDA(At, 1, 0); PG8_STAGE(PG8_SA(0, 1), a2 + hstep, voffA);
            PG8_WAIT_L(8); PG8_BAR; PG8_WAIT_L(0); PG8_MMA(0, 0, At, B0); PG8_BAR; PG8_SCHED;
            PG8_LDB(B1, 1, 1); PG8_STAGE(PG8_SB(1, 0), b3, voffB);
            PG8_BAR; PG8_WAIT_L(0); PG8_MMA(0, 1, At, B1); PG8_BAR;
            PG8_LDA(At, 1, 1); PG8_STAGE(PG8_SA(1, 0), a3, voffA);
            PG8_BAR; PG8_WAIT_L(0); PG8_MMA(1, 0, At, B0); PG8_BAR; PG8_SCHED;
            PG8_STAGE(PG8_SB(1, 1), b3 + hstep, voffB);
            PG8_WAIT_V(6); PG8_BAR; PG8_MMA(1, 1, At, B1); PG8_BAR;
            }
        }
        if constexpr (ALIGN_EPI) { if (wr == 0) PG8_BAR; }
        if constexpr (!Epi::AFTER_DRAIN) { E(acc, cur, wr, wc, fr, fq); S.done(cur); }
        if (!has_next) break;
#pragma unroll
        for (int a = 0; a < 2; ++a)
#pragma unroll
            for (int b = 0; b < 2; ++b)
#pragma unroll
                for (int m = 0; m < 4; ++m)
#pragma unroll
                    for (int n = 0; n < 2; ++n) acc[a][b][m][n] = (f32x4){0.f, 0.f, 0.f, 0.f};
        cur = nxt; cA = nA; cB = nB; ++ui;
        if constexpr (ALIGN_EPI) { if (wr == 1) PG8_BAR; }
    }
    PG8_WAIT_V(0);
    if constexpr (!ALIGN_EPI) { if (wr == 0) PG8_BAR; }
    PG8_BAR;
    if constexpr (Epi::AFTER_DRAIN) { E.fused(acc, cur, wr, wc, fr, fq, lds, wid, lane); S.done(cur); }
#undef PG8_SA
#undef PG8_SB
#undef PG8_STAGE
#undef PG8_LDA
#undef PG8_LDB
#undef PG8_MMA
#undef PG8_WAIT_V
#undef PG8_WAIT_L
#undef PG8_BAR
#undef PG8_SCHED
}
}
constexpr int DM = 2048, BATCH = 8, SEQ = 4096, MTOK = BATCH * SEQ;
constexpr int CONVW = 1024, QKVW = 3072, PROJW = 12288, DFF = 5632, UPW = 2 * DFF;
constexpr int QOFF = 3 * CONVW, KOFF = QOFF + QKVW, VOFF = KOFF + QKVW;
constexpr float ALPHA = 1.189207115002721f;
constexpr float LN_EPS = 1e-5f;
constexpr int NWAVES = 8, NTHREADS = 512;
constexpr int HALF_TOK = MTOK / 2;

constexpr size_t MiB = 1u << 20;
constexpr size_t WS_WIN = 2 * MiB, WS_WOUT = 50 * MiB, WS_WUP = 58 * MiB, WS_WDN = 102 * MiB;
constexpr size_t WS_XB = 124 * MiB;
constexpr size_t WS_OG0 = 124 * MiB, WS_OG1 = 188 * MiB, WS_HB = 124 * MiB;
constexpr size_t WS_PROJ = 252 * MiB;
constexpr size_t WS_MIXB = 252 * MiB;
constexpr size_t WS_HF = 380 * MiB;
constexpr size_t WS_ACT = 636 * MiB;
constexpr size_t WS_RAW = 988 * MiB;
constexpr size_t WS_LSE = 1020 * MiB;
constexpr size_t WS_BIAS2 = 1023 * MiB;
constexpr size_t WS_BAR = 0;
constexpr size_t WS_END = 1024 * MiB;
constexpr size_t OUT_YMIX = 0, OUT_OG2 = 128 * MiB, OUT_RAWC = 192 * MiB, OUT_RAWB = 194 * MiB;

constexpr int LDS_BYTES = 147456;
constexpr int LDS_TAB = 131072;
constexpr int LDS_XCH = 131072 + 1024;
constexpr int LDS_MISC = 131072 + 1024 + 8192;

#define GAS __attribute__((address_space(1)))
#define LAS __attribute__((address_space(3)))
typedef unsigned short bf16;
typedef unsigned v4u __attribute__((ext_vector_type(4)));
typedef unsigned v2u __attribute__((ext_vector_type(2)));
typedef float f32x4 __attribute__((ext_vector_type(4)));
typedef short bf16x8 __attribute__((ext_vector_type(8)));
typedef short s16x4 __attribute__((ext_vector_type(4)));
#define LDS_WAIT() asm volatile("s_waitcnt lgkmcnt(0)" ::: "memory")

__device__ __forceinline__ unsigned f2bf(float f) { unsigned u = __builtin_bit_cast(unsigned, f); return (u + 0x7fffu + ((u >> 16) & 1u)) >> 16; }
__device__ __forceinline__ unsigned pk2(float lo, float hi) { return f2bf(lo) | (f2bf(hi) << 16); }
typedef float f32x2_t __attribute__((ext_vector_type(2))); typedef __bf16 bf16x2_t __attribute__((ext_vector_type(2)));
__device__ __forceinline__ unsigned cvtpk(float lo, float hi) { f32x2_t v = {lo, hi}; bf16x2_t b = __builtin_convertvector(v, bf16x2_t); return __builtin_bit_cast(unsigned, b); }
__device__ __forceinline__ float bflo(unsigned w) { return __builtin_bit_cast(float, w << 16); }
__device__ __forceinline__ float bfhi(unsigned w) { return __builtin_bit_cast(float, w & 0xffff0000u); }

__device__ const unsigned char BUCKET_TAB[3][132] = {
 {0,1,2,3,4,5,6,7,8,9,10,11,12,13,14,15,16,16,16,16,16,16,17,17,17,17,17,17,17,17,18,18,18,18,18,18,18,18,18,18,19,19,19,19,19,19,19,19,19,19,19,19,19,19,20,20,20,20,20,20,20,20,20,20,20,20,20,20,20,20,20,20,20,21,21,21,21,21,21,21,21,21,21,21,21,21,21,21,21,21,21,21,21,21,21,21,21,21,21,22,22,22,22,22,22,22,22,22,22,22,22,22,22,22,22,22,22,22,22,22,22,22,22,22,22,22,22,22,22,0,0,0},
 {0,4,8,12,16,16,17,17,18,18,19,19,19,19,20,20,20,20,20,21,21,21,21,21,21,22,22,22,22,22,22,22,22,22,23,23,23,23,23,23,23,23,23,23,23,23,24,24,24,24,24,24,24,24,24,24,24,24,24,24,24,24,25,25,25,25,25,25,25,25,25,25,25,25,25,25,25,25,25,25,25,25,25,26,26,26,26,26,26,26,26,26,26,26,26,26,26,26,26,26,26,26,26,26,26,26,26,26,26,26,26,26,26,27,27,27,27,27,27,27,27,27,27,27,27,27,27,27,27,0,0,0},
 {0,16,18,19,20,21,21,22,22,23,23,23,24,24,24,24,25,25,25,25,25,26,26,26,26,26,26,26,26,27,27,27,27,27,27,27,27,27,27,28,28,28,28,28,28,28,28,28,28,28,28,28,29,29,29,29,29,29,29,29,29,29,29,29,29,29,29,29,29,29,30,30,30,30,30,30,30,30,30,30,30,30,30,30,30,30,30,30,30,30,30,30,30,30,30,31,31,31,31,31,31,31,31,31,31,31,31,31,31,31,31,31,31,31,31,31,31,31,31,31,31,31,31,31,31,31,31,31,31,0,0,0}};

__device__ __forceinline__ int mixdest(int sc) {
    if (sc >= 4096) return sc;
    const int stream = sc >> 10, ch = sc & 1023, mu = ch >> 6, r = ch & 63;
    const int base = 256 * mu + 32 * (r >> 4) + 8 * ((r >> 2) & 3) + (r & 3);
    return base + (stream == 0 ? 0 : stream == 2 ? 4 : stream == 1 ? 128 : 132);
}
template <int MODE  > __device__ __forceinline__ void p0_transpose_item(const float* W, int K, int N, bf16* WT, LAS float* scr, int item, int lane) {
    const int nblk = N / 32, kb = item / nblk, nb = item % nblk, k0 = 64 * kb, n0 = 32 * nb;
    int d0 = n0;
    if (MODE == 1) { d0 = n0 < DFF ? 256 * (n0 / 128) + (n0 % 128) : 256 * ((n0 - DFF) / 128) + 128 + ((n0 - DFF) % 128); }
#pragma unroll 8
    for (int i = 0; i < 32; ++i) { const int kk = 2 * i + (lane >> 5); scr[kk * 33 + (lane & 31)] = W[(size_t)(k0 + kk) * N + n0 + (lane & 31)]; }
    LDS_WAIT(); asm volatile("" ::: "memory");
    const int c = lane & 7;
#pragma unroll
    for (int j = 0; j < 4; ++j) { const int n = (lane >> 3) + 8 * j; const LAS float* s = scr + (8 * c) * 33 + n;
        v4u o; o.x = pk2(s[0 * 33], s[1 * 33]); o.y = pk2(s[2 * 33], s[3 * 33]); o.z = pk2(s[4 * 33], s[5 * 33]); o.w = pk2(s[6 * 33], s[7 * 33]);
        const int drow = (MODE == 2) ? mixdest(n0 + n) : d0 + n;
        *(v4u*)(WT + (size_t)drow * K + k0 + 8 * c) = o; }
    LDS_WAIT(); asm volatile("" ::: "memory");
}
__device__ __forceinline__ float wave_sum(float v) {
#pragma unroll
    for (int o = 1; o < 64; o <<= 1) v += __shfl_xor(v, o);
    return v;
}

#define RLX_AGENT __ATOMIC_RELAXED, __HIP_MEMORY_SCOPE_AGENT
#define XB_TMO      128
#define XB_XCNT(j)  (256  + 64 * (j))
#define XB_XSUB(j)  (1280 + 64 * (j))
#define XB_XGEN(j)  (2304 + 64 * (j))
#define XB_TOP      3328
#define XB_TOPGEN   3392
#define XCD_BAR_WORDS 3456
#define XB_SPIN_CAP (1u << 18)

__device__ __forceinline__ unsigned xb_ld(unsigned* p)              { return __hip_atomic_load(p, __ATOMIC_RELAXED, __HIP_MEMORY_SCOPE_AGENT); }
__device__ __forceinline__ unsigned xb_add(unsigned* p, unsigned v) { return __hip_atomic_fetch_add(p, v, __ATOMIC_RELAXED, __HIP_MEMORY_SCOPE_AGENT); }
__device__ __forceinline__ unsigned xb_xcc_id() { return (unsigned)__builtin_amdgcn_s_getreg((3 << 11) | 20) & 0xFu; }
#define XB_SPIN(cond, bar) do { unsigned _sp = 0; while (cond) { __builtin_amdgcn_s_sleep(1); \
    if ((++_sp & 255u) == 0u) { if (xb_ld(&(bar)[XB_TMO])) break; if (_sp > XB_SPIN_CAP) { atomicAdd(&(bar)[XB_TMO], 1u); break; } } } } while (0)

struct XcdBarrier {
    unsigned* bar; unsigned x;
    volatile LAS unsigned* st;
};

__device__ __forceinline__ XcdBarrier xcd_barrier_post(unsigned* bar, volatile LAS unsigned* st) {
    XcdBarrier b; b.bar = bar; b.x = xb_xcc_id(); b.st = st;
    if (threadIdx.x == 0) (void)xb_add(&bar[XB_XCNT(b.x)], 1u);
    return b;
}
__device__ __forceinline__ void xcd_barrier_complete(unsigned* bar, unsigned x, unsigned& nloc, unsigned& nx) {
    const unsigned G = gridDim.x * gridDim.y * gridDim.z;
    unsigned sum, cnt, mine, sp = 0u;
    for (;;) {
        sum = 0u; cnt = 0u; mine = 0u;
#pragma unroll
        for (unsigned j = 0; j < 16; ++j) { const unsigned c = xb_ld(&bar[XB_XCNT(j)]); sum += c; cnt += (c > 0u) ? 1u : 0u; mine = (j == x) ? c : mine; }
        if (sum == G) break;
        __builtin_amdgcn_s_sleep(1);
        if ((++sp & 255u) == 0u) { if (xb_ld(&bar[XB_TMO])) break; if (sp > XB_SPIN_CAP) { atomicAdd(&bar[XB_TMO], 1u); break; } }
    }
    nloc = mine > 0u ? mine : 1u; nx = cnt > 0u ? cnt : 1u;
}

__device__ __forceinline__ void xcd_barrier(const XcdBarrier& b) {
    asm volatile("s_waitcnt vmcnt(0)" ::: "memory");
    __syncthreads();
    if (threadIdx.x == 0) {
        unsigned* bar = b.bar;
        __builtin_amdgcn_s_waitcnt(0);
        unsigned nloc = b.st[0], nx = b.st[1];
        if (nloc == 0u) { xcd_barrier_complete(bar, b.x, nloc, nx); b.st[0] = nloc; b.st[1] = nx; }
        const unsigned old = xb_add(&bar[XB_XSUB(b.x)], 1u);
        const unsigned gen = old / nloc;
        if (old + 1u == (gen + 1u) * nloc) {
            __builtin_amdgcn_fence(__ATOMIC_RELEASE, "agent");
            asm volatile("s_waitcnt vmcnt(0)" ::: "memory");
            const unsigned og = xb_add(&bar[XB_TOP], 1u);
            const unsigned tg = og / nx;
            if (og + 1u == (tg + 1u) * nx) xb_add(&bar[XB_TOPGEN], 1u);
            else XB_SPIN(xb_ld(&bar[XB_TOPGEN]) == tg, bar);
            __builtin_amdgcn_fence(__ATOMIC_ACQUIRE, "agent");
            xb_add(&bar[XB_XGEN(b.x)], 1u);
            asm volatile("s_waitcnt vmcnt(0)" ::: "memory");
        } else {
            XB_SPIN(xb_ld(&bar[XB_XGEN(b.x)]) == gen, bar);
            __builtin_amdgcn_fence(__ATOMIC_ACQUIRE, "agent");
            asm volatile("s_waitcnt vmcnt(0)" ::: "memory");
        }
    }
    __syncthreads();
}

__device__ __forceinline__ unsigned off_b(unsigned row, unsigned ch) { return 256u * row + 16u * (ch ^ (((row & 3) << 2) | ((row >> 2) & 3))); }
__device__ __forceinline__ s16x4 vtr(unsigned lds_addr) {
    return __builtin_bit_cast(s16x4, __builtin_amdgcn_ds_read_tr16_b64_v4i16((LAS s16x4*)(uintptr_t)lds_addr)); }

struct AttnUnit { int b, g, h, r, n; };
struct AttnRegs { v4u kr[4], vr[4]; bf16x8 qf[4]; float tabv; };
__device__ __forceinline__ AttnUnit attn_decode(int uid) {
    AttnUnit u; const int rn = uid & 31; u.h = (uid >> 5) & 7; const int bg = uid >> 8; u.g = bg % 3; u.b = bg / 3;
    const int nb = 32 >> (2 * u.g); u.r = rn / nb; u.n = rn % nb; return u; }
__device__ __forceinline__ const bf16* attn_plane(const bf16* qkv, int ty, const AttnUnit& u) { return qkv + ((size_t)(((ty * 3 + u.g) * 8 + u.b) * 8 + u.h) << 19); }
__device__ __forceinline__ void attn_issue(AttnRegs& R, const AttnUnit& u, int blk, bool with_q, const bf16* qkv, const float* bias2) {
    const int tid = threadIdx.x, lane = tid & 63, w = tid >> 6;
    const int L = 4096 >> (2 * u.g), gh = u.g * 8 + u.h;
    const int ch = tid & 15, r0 = tid >> 4;
    if (with_q) R.tabv = bias2[gh * 192 + (tid < 192 ? tid : 0)];
    const size_t rb = (size_t)(u.r * L + blk * 128 + r0) * 128 + ch * 8;
    const bf16* kp = attn_plane(qkv, 1, u) + rb; const bf16* vp = attn_plane(qkv, 2, u) + rb;
#pragma unroll
    for (int j = 0; j < 4; ++j) { R.kr[j] = *(const v4u*)(kp + (size_t)j * 32 * 128); R.vr[j] = *(const v4u*)(vp + (size_t)j * 32 * 128); }
    if (with_q) {
        const int qi = 16 * w + (lane & 15), kg = lane >> 4;
        const bf16* qp = attn_plane(qkv, 0, u) + (size_t)(u.r * L + u.n * 128 + qi) * 128 + 8 * kg;
#pragma unroll
        for (int s = 0; s < 4; ++s) R.qf[s] = *(const bf16x8*)(qp + 32 * s);
    }
}
__device__ __forceinline__ void attn_commit(const AttnRegs& R, int blk, bool with_tab, LAS unsigned char* lds) {
    const int tid = threadIdx.x; const int ch = tid & 15, r0 = tid >> 4;
    LAS unsigned char* Ks = lds; LAS unsigned char* Vs = lds + 65536; LAS float* tab = (LAS float*)(lds + LDS_TAB);
#pragma unroll
    for (int j = 0; j < 4; ++j) { const unsigned row = (blk & 1) * 128 + r0 + 32 * j; *(LAS v4u*)(Ks + off_b(row, ch)) = R.kr[j]; *(LAS v4u*)(Vs + off_b(row, ch)) = R.vr[j]; }
    if (with_tab && tid < 192) tab[tid] = R.tabv;
}
__device__ __forceinline__ void attn_compute(LAS unsigned char* lds, const bf16x8 (&qf)[4], const AttnUnit& u, bf16* og, float* lse) {
    const int tid = threadIdx.x, lane = tid & 63, w = __builtin_amdgcn_readfirstlane(tid >> 6);
    const int d = 1 << (2 * u.g); const int n = u.n, h = u.h;
    const unsigned par = (unsigned)((n + 1) & 1) << 15;
    LAS unsigned char* Ks = lds; LAS unsigned char* Vs = lds + 65536; LAS float* tab = (LAS float*)(lds + LDS_TAB);
    const int qi = 16 * w + (lane & 15), kg = lane >> 4;
    const size_t qtok = (size_t)u.b * SEQ + (size_t)(n * 128 + qi) * d + u.r;
    const int ks0 = w >> 1;
    const int i15 = lane & 15;
    f32x4 sc[5][2];
    const unsigned krow = 8 * (i15 >> 2) + (i15 & 3);
#pragma unroll
    for (int kk = 0; kk < 5; ++kk) {
        const int ks = ks0 + kk;
        bf16x8 kf[2][4];
#pragma unroll
        for (int T = 0; T < 2; ++T)
#pragma unroll
            for (int s = 0; s < 4; ++s) kf[T][s] = *(const LAS bf16x8*)(Ks + (off_b(32 * ks + krow + 4 * T, 4 * s + kg) ^ par));
#pragma unroll
        for (int T = 0; T < 2; ++T) {
            f32x4 a = {0.f, 0.f, 0.f, 0.f};
#pragma unroll
            for (int s = 0; s < 4; ++s) a = __builtin_amdgcn_mfma_f32_16x16x32_bf16(kf[T][s], qf[s], a, 0, 0, 0);
            sc[kk][T] = a;
        }
    }
    float tb[5][2][4];
    { const LAS float* tp = tab + (31 - 16 * (w & 1) - i15 + 8 * kg);
#pragma unroll
      for (int kk = 0; kk < 5; ++kk)
#pragma unroll
          for (int T = 0; T < 2; ++T)
#pragma unroll
              for (int jj = 0; jj < 4; ++jj) tb[kk][T][jj] = tp[32 * kk + 4 * T + jj]; }
    const float SCL = 0.08838834764831845f * 1.4426950408889634f;
    float mx = -1e30f;
#pragma unroll
    for (int kk = 0; kk < 5; ++kk) {
        const bool dead = (n == 0) && (ks0 + kk < 4);
#pragma unroll
        for (int T = 0; T < 2; ++T)
#pragma unroll
            for (int jj = 0; jj < 4; ++jj) { float v = sc[kk][T][jj] * SCL + tb[kk][T][jj]; v = dead ? -1e30f : v; sc[kk][T][jj] = v; mx = fmaxf(mx, v); }
    }
    mx = fmaxf(mx, __shfl_xor(mx, 16)); mx = fmaxf(mx, __shfl_xor(mx, 32));
    float l = 0.f;
    bf16x8 pf[5];
#pragma unroll
    for (int kk = 0; kk < 5; ++kk) {
        float e[8];
#pragma unroll
        for (int T = 0; T < 2; ++T)
#pragma unroll
            for (int jj = 0; jj < 4; ++jj) { const float p = __builtin_amdgcn_exp2f(sc[kk][T][jj] - mx); e[4 * T + jj] = p; l += p; }
        v4u pw; pw.x = cvtpk(e[0], e[1]); pw.y = cvtpk(e[2], e[3]); pw.z = cvtpk(e[4], e[5]); pw.w = cvtpk(e[6], e[7]);
        pf[kk] = __builtin_bit_cast(bf16x8, pw);
    }
    l += __shfl_xor(l, 16); l += __shfl_xor(l, 32);
    f32x4 o[8];
#pragma unroll
    for (int c = 0; c < 8; ++c) o[c] = (f32x4){0.f, 0.f, 0.f, 0.f};
    const unsigned vbase = (unsigned)(uintptr_t)Vs;
    const unsigned q4 = (lane & 15) >> 2, p4 = lane & 3;
    s16x4 vlo[2][8], vhi[2][8];
#define ATT_VLOAD(kk_, buf_) do { const unsigned r0_ = 32 * (ks0 + (kk_)) + 8 * kg + q4; _Pragma("unroll") for (int c = 0; c < 8; ++c) { \
        vlo[buf_][c] = vtr(vbase + ((off_b(r0_, 2 * c + (p4 >> 1)) + 8 * (p4 & 1)) ^ par)); vhi[buf_][c] = vtr(vbase + ((off_b(r0_ + 4, 2 * c + (p4 >> 1)) + 8 * (p4 & 1)) ^ par)); } } while (0)
    ATT_VLOAD(0, 0);
#pragma unroll
    for (int kk = 0; kk < 5; ++kk) {
        if (kk < 4) ATT_VLOAD(kk + 1, (kk + 1) & 1);
#pragma unroll
        for (int c = 0; c < 8; ++c) {
            const s16x4 lo = vlo[kk & 1][c], hi = vhi[kk & 1][c];
            const bf16x8 vf = (bf16x8){lo[0], lo[1], lo[2], lo[3], hi[0], hi[1], hi[2], hi[3]};
            o[c] = __builtin_amdgcn_mfma_f32_16x16x32_bf16(vf, pf[kk], o[c], 0, 0, 0);
        }
    }
#undef ATT_VLOAD
    const float rl = 1.0f / l;
    bf16* op = og + qtok * 1024 + h * 128 + 4 * kg;
#pragma unroll
    for (int c = 0; c < 8; ++c) { v2u wv; wv.x = cvtpk(o[c][0] * rl, o[c][1] * rl); wv.y = cvtpk(o[c][2] * rl, o[c][3] * rl); *(v2u*)(op + 16 * c) = wv; }
    if (kg == 0) lse[qtok * 8 + h] = mx + __builtin_amdgcn_logf(l);
}

struct Args { const float* in[13]; float* out; unsigned char* ws; };
__global__ void __launch_bounds__(NTHREADS, 2) fwd_megakernel(Args args) {
    extern __shared__ __attribute__((aligned(16))) unsigned char lds_raw[];
    LAS unsigned char* lds = (LAS unsigned char*)lds_raw;
    cg::grid_group grid = cg::this_grid();
    const int G = gridDim.x, bx = blockIdx.x;
    const int vcu = (G % 8 == 0) ? (bx % 8) * (G / 8) + bx / 8 : bx;
    unsigned char* ws = args.ws; unsigned char* outb = (unsigned char*)args.out;
    const float* x = args.in[0]; const float* w_in = args.in[1]; const float* conv_mix_w = args.in[2]; const float* w_out = args.in[3];
    const float* ln1_g = args.in[4]; const float* ln1_b = args.in[5]; const float* w_up = args.in[6]; const float* ffn_conv_w = args.in[7];
    const float* ffn_conv_b = args.in[8]; const float* w_down = args.in[9]; const float* ln2_g = args.in[10]; const float* ln2_b = args.in[11];
    const float* rel_bias = args.in[12];
    bf16* WIN = (bf16*)(ws + WS_WIN); bf16* WOUT = (bf16*)(ws + WS_WOUT); bf16* WUP = (bf16*)(ws + WS_WUP); bf16* WDN = (bf16*)(ws + WS_WDN);
    bf16* XB = (bf16*)(ws + WS_XB); bf16* PROJ = (bf16*)(ws + WS_PROJ); float* HF = (float*)(ws + WS_HF); bf16* MIXB = (bf16*)(ws + WS_MIXB); bf16* HB = (bf16*)(ws + WS_HB);
    bf16* ACT = (bf16*)(ws + WS_ACT); float* RAW = (float*)(ws + WS_RAW); float* LSE = (float*)(ws + WS_LSE); float* BIAS2 = (float*)(ws + WS_BIAS2);
    bf16* OG0 = (bf16*)(ws + WS_OG0); bf16* OG1 = (bf16*)(ws + WS_OG1); bf16* OG2 = (bf16*)(outb + OUT_OG2);
    bf16* YMIX = (bf16*)(outb + OUT_YMIX); float* RAWC = (float*)(outb + OUT_RAWC); float* RAWB = (float*)(outb + OUT_RAWB);
#define PHASE_IDS() int tid_p = threadIdx.x; asm volatile("" : "+v"(tid_p)); const int lane = tid_p & 63; const int wave_p = __builtin_amdgcn_readfirstlane(tid_p >> 6); \
    const int gw = vcu * NWAVES + wave_p, NGW = G * NWAVES; const size_t gt = (size_t)bx * NTHREADS + tid_p, NGT = (size_t)G * NTHREADS; (void)lane; (void)gw; (void)NGW; (void)gt; (void)NGT

    unsigned* barw = (unsigned*)(ws + WS_BAR);
    volatile LAS unsigned* misc = (volatile LAS unsigned*)(lds + LDS_MISC);
    if (threadIdx.x < 2) misc[threadIdx.x] = 0u;
    if (bx == 0) { for (int i = threadIdx.x; i < XCD_BAR_WORDS; i += NTHREADS) barw[i] = 0u; }
    {
        PHASE_IDS();
        LAS float* scr = (LAS float*)(lds + wave_p * 16384);
        constexpr int I_IN = (DM / 64) * (PROJW / 32), I_OUT = (DM / 64) * (DM / 32), I_UP = (DM / 64) * (UPW / 32), I_DN = (DFF / 64) * (DM / 32);
        constexpr int NITEMS = I_IN + I_OUT + I_UP + I_DN;
        for (int it = gw; it < NITEMS; it += NGW) {
            int r = it;
            if (r < I_IN) { p0_transpose_item<2>(w_in, DM, PROJW, WIN, scr, r, lane); continue; } r -= I_IN;
            if (r < I_OUT) { p0_transpose_item<0>(w_out, DM, DM, WOUT, scr, r, lane); continue; } r -= I_OUT;
            if (r < I_UP) { p0_transpose_item<1>(w_up, DM, UPW, WUP, scr, r, lane); continue; } r -= I_UP;
            p0_transpose_item<0>(w_down, DFF, DM, WDN, scr, r, lane);
        }
        if (gt < 24 * 192) { const int gh = (int)gt / 192, j = (int)gt % 192, steps = 159 - j;
            BIAS2[gt] = (steps >= 0 && steps <= 128) ? rel_bias[(int)BUCKET_TAB[gh >> 3][steps] * 24 + gh] * 1.4426950408889634f : -1e30f; }
        const size_t n8 = (size_t)MTOK * DM / 8;
        for (size_t i = gt; i < n8; i += NGT) { const f32x4 a = *(const f32x4*)(x + i * 8), c = *(const f32x4*)(x + i * 8 + 4);
            v4u o; o.x = cvtpk(a[0], a[1]); o.y = cvtpk(a[2], a[3]); o.z = cvtpk(c[0], c[1]); o.w = cvtpk(c[2], c[3]); *(v4u*)(XB + i * 8) = o; }
    }
    grid.sync();
    const XcdBarrier xbar = xcd_barrier_post(barw, misc);
    {
        pg8::Gemm g{XB, WIN, MTOK, PROJW, DM}; pg8::StaticOrder S; S.init(MTOK, PROJW, G, bx);
        pg8::EpiProj E{PROJ, PROJW, YMIX, RAWC, RAWB, conv_mix_w, (LAS float*)(lds + LDS_XCH)};
        pg8::gemm_phase<pg8::EpiProj, pg8::StaticOrder, true, true>(lds, g, S, E);
    }
    xcd_barrier(xbar);
    {
        constexpr int NUNITS = BATCH * 3 * 8 * 32;
        const int per = (NUNITS + G - 1) / G;
        const int u0 = vcu * per, u1 = (u0 + per < NUNITS) ? u0 + per : NUNITS;
        { const v4u z = {0u, 0u, 0u, 0u}; for (int i = threadIdx.x; i < 8192; i += NTHREADS) *(LAS v4u*)(lds + 16 * i) = z; }
        asm volatile("s_waitcnt lgkmcnt(0)" ::: "memory"); __builtin_amdgcn_s_barrier(); asm volatile("" ::: "memory");
        AttnRegs R;
        if (u0 < u1) { const AttnUnit un = attn_decode(u0);
            if (un.n > 0) { attn_issue(R, un, un.n - 1, false, PROJ, BIAS2); attn_commit(R, un.n - 1, false, lds); }
            attn_issue(R, un, un.n, true, PROJ, BIAS2); }
        for (int uid = u0; uid < u1; ++uid) {
            const AttnUnit u = attn_decode(uid);
            attn_commit(R, u.n, true, lds);
            bf16x8 qf[4];
#pragma unroll
            for (int s4 = 0; s4 < 4; ++s4) qf[s4] = R.qf[s4];
            asm volatile("s_waitcnt lgkmcnt(0)" ::: "memory"); __builtin_amdgcn_s_barrier(); asm volatile("" ::: "memory");
            if (uid + 1 < u1) { const AttnUnit un = attn_decode(uid + 1); attn_issue(R, un, un.n, true, PROJ, BIAS2); }
            bf16* og = u.g == 0 ? OG0 : (u.g == 1 ? OG1 : OG2);
            attn_compute(lds, qf, u, og, LSE + (size_t)u.g * MTOK * 8);
            asm volatile("s_waitcnt lgkmcnt(0)" ::: "memory"); __builtin_amdgcn_s_barrier(); asm volatile("" ::: "memory");
        }
    }
    xcd_barrier(xbar);
    {
        PHASE_IDS();
        constexpr int TB = 32;
        const size_t nitems = (size_t)(MTOK / TB) * 128;
        for (size_t it = gt; it < nitems; it += NGT) {
            const size_t tok0 = (it >> 7) * TB; const int ac = (int)(it & 127), h = ac >> 4, c0 = ac * 8;
#pragma unroll 4
            for (int t = 0; t < TB; ++t) {
                const size_t tok = tok0 + t;
                const float l0 = LSE[tok * 8 + h], l1 = LSE[(size_t)MTOK * 8 + tok * 8 + h], l2 = LSE[(size_t)2 * MTOK * 8 + tok * 8 + h];
                const float mm = fmaxf(l0, fmaxf(l1, l2));
                float w0 = __builtin_amdgcn_exp2f(l0 - mm), w1 = __builtin_amdgcn_exp2f(l1 - mm), w2 = __builtin_amdgcn_exp2f(l2 - mm);
                const float inv = 1.0f / (w0 + w1 + w2); w0 *= inv; w1 *= inv; w2 *= inv;
                const v4u a0 = *(const v4u*)(OG0 + tok * 1024 + c0), a1 = *(const v4u*)(OG1 + tok * 1024 + c0), a2 = *(const v4u*)(OG2 + tok * 1024 + c0);
                v4u o;
                o.x = cvtpk(w0 * bflo(a0.x) + w1 * bflo(a1.x) + w2 * bflo(a2.x), w0 * bfhi(a0.x) + w1 * bfhi(a1.x) + w2 * bfhi(a2.x));
                o.y = cvtpk(w0 * bflo(a0.y) + w1 * bflo(a1.y) + w2 * bflo(a2.y), w0 * bfhi(a0.y) + w1 * bfhi(a1.y) + w2 * bfhi(a2.y));
                o.z = cvtpk(w0 * bflo(a0.z) + w1 * bflo(a1.z) + w2 * bflo(a2.z), w0 * bfhi(a0.z) + w1 * bfhi(a1.z) + w2 * bfhi(a2.z));
                o.w = cvtpk(w0 * bflo(a0.w) + w1 * bflo(a1.w) + w2 * bflo(a2.w), w0 * bfhi(a0.w) + w1 * bfhi(a1.w) + w2 * bfhi(a2.w));
                *(v4u*)(YMIX + tok * DM + CONVW + c0) = o;
            }
        }
        const size_t nfix = (size_t)(MTOK / 256) * 2 * (CONVW / 4);
        for (size_t it = gt; it < nfix; it += NGT) {
            const int c = 4 * (int)(it % (CONVW / 4)); const int pk = (int)(it / (CONVW / 4)); const int k = pk & 1, pm = pk >> 1;
            if ((pm & 15) == 0) continue;
            const f32x4 cur = *(const f32x4*)(RAWC + ((size_t)pm * 4 + k) * 1024 + c);
            const f32x4 p1 = *(const f32x4*)(RAWC + (k == 0 ? ((size_t)(pm - 1) * 4 + 3) : ((size_t)pm * 4 + 0)) * 1024 + c);
            const f32x4 p2 = *(const f32x4*)(RAWC + ((size_t)(pm - 1) * 4 + (k == 0 ? 2 : 3)) * 1024 + c);
            const f32x4 gb = *(const f32x4*)(RAWB + ((size_t)pm * 2 + k) * 1024 + c);
            const f32x4 w0 = *(const f32x4*)(conv_mix_w + c), w1 = *(const f32x4*)(conv_mix_w + CONVW + c), w2 = *(const f32x4*)(conv_mix_w + 2 * CONVW + c);
            const f32x4 y = gb * (w2 * cur + w1 * p1 + w0 * p2);
            v2u wv; wv.x = cvtpk(y[0], y[1]); wv.y = cvtpk(y[2], y[3]);
            *(v2u*)(YMIX + ((size_t)pm * 256 + k) * DM + c) = wv;
        }
    }
    xcd_barrier(xbar);
    {
        pg8::Gemm g{YMIX, WOUT, MTOK, DM, DM}; pg8::StaticOrder S; S.init(MTOK, DM, G, bx);
        pg8::EpiBf16 E{MIXB, DM};
        pg8::gemm_phase<pg8::EpiBf16, pg8::StaticOrder, true, true>(lds, g, S, E);
    }
    xcd_barrier(xbar);
    { PHASE_IDS();
    for (int m = gw; m < MTOK; m += NGW) {
        float* row = HF + (size_t)m * DM; const float* xr = x + (size_t)m * DM; const bf16* mr = MIXB + (size_t)m * DM; f32x4 v[8]; float s = 0.f;
#pragma unroll
        for (int j = 0; j < 8; ++j) { const int c = 4 * (lane + 64 * j); const f32x4 xv = *(const f32x4*)(xr + c); const v2u mv = *(const v2u*)(mr + c);
            v[j] = xv * ALPHA + (f32x4){bflo(mv.x), bfhi(mv.x), bflo(mv.y), bfhi(mv.y)}; s += (v[j][0] + v[j][1]) + (v[j][2] + v[j][3]); }
        const float mean = wave_sum(s) * (1.f / DM); float s2 = 0.f;
#pragma unroll
        for (int j = 0; j < 8; ++j) { v[j] = v[j] - mean; s2 += (v[j][0] * v[j][0] + v[j][1] * v[j][1]) + (v[j][2] * v[j][2] + v[j][3] * v[j][3]); }
        const float rstd = 1.f / sqrtf(wave_sum(s2) * (1.f / DM) + LN_EPS);
#pragma unroll
        for (int j = 0; j < 8; ++j) { const int c = 4 * (lane + 64 * j); const f32x4 gg = *(const f32x4*)(ln1_g + c), bb = *(const f32x4*)(ln1_b + c);
            const f32x4 o = v[j] * rstd * gg + bb; *(f32x4*)(row + c) = o;
            v2u wv; wv.x = cvtpk(o[0], o[1]); wv.y = cvtpk(o[2], o[3]); *(v2u*)(HB + (size_t)m * DM + c) = wv; }
    } }
    xcd_barrier(xbar);
    {
        pg8::Gemm g{HB, WUP, MTOK, UPW, DM}; pg8::StaticOrder S; S.init(MTOK, UPW, G, bx);
        pg8::EpiFfn E{ACT, RAW, ffn_conv_w, ffn_conv_b, (LAS float*)(lds + LDS_XCH), DFF};
        pg8::gemm_phase<pg8::EpiFfn, pg8::StaticOrder, true, true>(lds, g, S, E);
    }
    xcd_barrier(xbar);
    {
        PHASE_IDS();
        const size_t nitems = (size_t)(MTOK / 256) * 2 * (DFF / 4);
        for (size_t it = gt; it < nitems; it += NGT) {
            const int c4 = (int)(it % (DFF / 4)); const int pk = (int)(it / (DFF / 4)); const int k = pk & 1, pm = pk >> 1;
            if ((pm & 15) == 0) continue;
            const int c = 4 * c4, col = (c >> 7) * 256 + (c & 127);
            const float* rc = RAW + ((size_t)pm * 4 + k) * UPW + col;
            const float* r1 = k == 0 ? RAW + ((size_t)(pm - 1) * 4 + 3) * UPW + col : RAW + ((size_t)pm * 4 + 0) * UPW + col;
            const float* r2 = k == 0 ? RAW + ((size_t)(pm - 1) * 4 + 2) * UPW + col : RAW + ((size_t)(pm - 1) * 4 + 3) * UPW + col;
            f32x4 v[2];
#pragma unroll
            for (int bj = 0; bj < 2; ++bj) {
                const f32x4 w0 = *(const f32x4*)(ffn_conv_w + bj * DFF + c), w1 = *(const f32x4*)(ffn_conv_w + UPW + bj * DFF + c), w2 = *(const f32x4*)(ffn_conv_w + 2 * UPW + bj * DFF + c), bb = *(const f32x4*)(ffn_conv_b + bj * DFF + c);
                v[bj] = w2 * *(const f32x4*)(rc + bj * 128) + w1 * *(const f32x4*)(r1 + bj * 128) + w0 * *(const f32x4*)(r2 + bj * 128) + bb;
            }
            float y[4];
#pragma unroll
            for (int jj = 0; jj < 4; ++jj) { const float gg = v[1][jj]; y[jj] = v[0][jj] * gg / (1.0f + __expf(-gg)); }
            v2u wv; wv.x = cvtpk(y[0], y[1]); wv.y = cvtpk(y[2], y[3]);
            *(v2u*)(ACT + ((size_t)pm * 256 + k) * DFF + c) = wv;
        }
    }
    xcd_barrier(xbar);
    {
        pg8::Gemm g{ACT, WDN, MTOK, DM, DFF}; pg8::StaticOrder S; S.init(MTOK, DM, G, bx);
        pg8::EpiBf16 E{MIXB, DM};
        pg8::gemm_phase<pg8::EpiBf16, pg8::StaticOrder, true, true>(lds, g, S, E);
    }
    xcd_barrier(xbar);
    { PHASE_IDS();
    for (int m = gw; m < MTOK; m += NGW) {
        const float* row = HF + (size_t)m * DM; const bf16* mr = MIXB + (size_t)m * DM; f32x4 v[8]; float s = 0.f;
#pragma unroll
        for (int j = 0; j < 8; ++j) { const int c = 4 * (lane + 64 * j); const f32x4 hv = *(const f32x4*)(row + c); const v2u mv = *(const v2u*)(mr + c);
            v[j] = hv * ALPHA + (f32x4){bflo(mv.x), bfhi(mv.x), bflo(mv.y), bfhi(mv.y)}; s += (v[j][0] + v[j][1]) + (v[j][2] + v[j][3]); }
        const float mean = wave_sum(s) * (1.f / DM); float s2 = 0.f;
#pragma unroll
        for (int j = 0; j < 8; ++j) { v[j] = v[j] - mean; s2 += (v[j][0] * v[j][0] + v[j][1] * v[j][1]) + (v[j][2] * v[j][2] + v[j][3] * v[j][3]); }
        const float rstd = 1.f / sqrtf(wave_sum(s2) * (1.f / DM) + LN_EPS);
#pragma unroll
        for (int j = 0; j < 8; ++j) { const int c = 4 * (lane + 64 * j); const f32x4 gg = *(const f32x4*)(ln2_g + c), bb = *(const f32x4*)(ln2_b + c);
            *(f32x4*)(args.out + (size_t)m * DM + c) = v[j] * rstd * gg + bb; }
    } }
}

extern "C" void kernel_launch(void* const* d_in, const int* in_sizes, int n_in, void* d_out, int out_size, void* d_ws, size_t ws_size, hipStream_t stream) {
    static int grid = 0;
    if (grid == 0) {
        if (n_in != 13 || in_sizes[0] != MTOK * DM || out_size != MTOK * DM || ws_size < WS_END) { fprintf(stderr, "kernel_launch: unexpected shapes (n_in %d, ws %zu)\n", n_in, ws_size); grid = -1; return; }
        int dev = 0, cus = 0, per_cu = 0;
        (void)hipGetDevice(&dev); (void)hipDeviceGetAttribute(&cus, hipDeviceAttributeMultiprocessorCount, dev);
        if (hipFuncSetAttribute((const void*)fwd_megakernel, hipFuncAttributeMaxDynamicSharedMemorySize, LDS_BYTES) != hipSuccess) { fprintf(stderr, "kernel_launch: hipFuncSetAttribute failed\n"); grid = -1; return; }
        if (hipOccupancyMaxActiveBlocksPerMultiprocessor(&per_cu, (const void*)fwd_megakernel, NTHREADS, LDS_BYTES) != hipSuccess || per_cu < 1) { fprintf(stderr, "kernel_launch: occupancy query gave %d\n", per_cu); per_cu = 1; }
        (void)hipGetLastError();
        grid = cus;
    }
    if (grid < 0) return;
    Args a{};
    for (int i = 0; i < 13; ++i) a.in[i] = (const float*)d_in[i];
    a.out = (float*)d_out; a.ws = (unsigned char*)d_ws;
    void* kargs[] = {&a};
    hipError_t e = hipLaunchCooperativeKernel((const void*)fwd_megakernel, dim3(grid), dim3(NTHREADS), kargs, LDS_BYTES, stream);
    if (e != hipSuccess) fprintf(stderr, "kernel_launch: cooperative launch failed: %s (grid %d)\n", hipGetErrorString(e), grid);
}
```

```cpp
#include <hip/hip_runtime.h>
#include <hip/hip_cooperative_groups.h>
#include <cstdio>
#include <cstdint>
namespace cg = cooperative_groups;
namespace pg8 {
#define PG8_LAS __attribute__((address_space(3)))
typedef unsigned short bf16_t;
typedef short bf16x8 __attribute__((ext_vector_type(8)));
typedef float f32x4 __attribute__((ext_vector_type(4)));
typedef unsigned u32x4 __attribute__((ext_vector_type(4)));
typedef unsigned u32x2 __attribute__((ext_vector_type(2)));
constexpr int BM = 256, BK = 64, HALF = 128, HTB = HALF * BK * 2  , STAGE_BYTES = 8 * HTB, NXCD = 8, WGM = 8;

__host__ __device__ __forceinline__ int lds_byte(int r, int c) { const int st = (r >> 4) * 2 + (c >> 5), rr = r & 15, cc = c & 31, ob = rr * 64 + cc * 2; return st * 1024 + (ob ^ (((ob >> 9) & 1) << 5)); }
__host__ __device__ __forceinline__ void stage_rc(int b, int& R, int& C) { const int st = b / 1024, sb = b % 1024, swz = sb ^ (((sb >> 9) & 1) << 5); R = (st >> 1) * 16 + swz / 64; C = (st & 1) * 32 + (swz % 64) / 2; }
__host__ __device__ __forceinline__ int perm32(int rho) { const int n = rho >> 4, i = rho & 15; return 8 * (i >> 2) + 4 * n + (i & 3); }

struct Unit { int pm, pn; };
struct Gemm { const bf16_t* A; const bf16_t* Bt; int M, N, K; };

struct StaticOrder {
    int nM, nN, nwg, G, c;
    __host__ __device__ void init(int M, int N, int G_, int c_) { nM = M / BM; nN = N / BM; nwg = nM * nN; G = G_; c = c_; }
    __host__ __device__ bool next(int i, Unit& u) const {
        const long L = (long)i * G + c; if (L >= nwg) return false;
        int wgid = (int)L; { const int q = nwg / NXCD, r = nwg % NXCD, xcd = wgid % NXCD, off = wgid / NXCD; wgid = (xcd < r ? xcd * (q + 1) : r * (q + 1) + (xcd - r) * q) + off; }
        const int nig = WGM * nN, gid = wgid / nig, fm = gid * WGM, gsz = (nM - fm) < WGM ? (nM - fm) : WGM;
        u.pm = fm + ((wgid % nig) % gsz); u.pn = (wgid % nig) / gsz; return true;
    }
    __device__ __forceinline__ void a_ready(const Unit&) const {}
    __device__ __forceinline__ void done(const Unit&) const {}
};

__device__ __forceinline__ unsigned cvt_pk_bf16(float lo, float hi) { unsigned r; asm volatile("v_cvt_pk_bf16_f32 %0, %1, %2" : "=v"(r) : "v"(lo), "v"(hi)); return r; }
struct EpiBf16 {
    static constexpr bool PERM = true, AFTER_DRAIN = false;
    bf16_t* O; int ldc;
    __device__ __forceinline__ void operator()(const f32x4 (&acc)[2][2][4][2], const Unit& u, int wr, int wc, int fr, int fq) const {
        const int row0 = u.pm * BM + wr * 64 + fr; const int col0 = u.pn * BM + wc * 32 + 8 * fq;
#pragma unroll
        for (int ai = 0; ai < 2; ++ai)
#pragma unroll
            for (int m = 0; m < 4; ++m) { bf16_t* rowp = O + (size_t)(row0 + ai * HALF + m * 16) * ldc + col0;
#pragma unroll
                for (int bj = 0; bj < 2; ++bj) { const f32x4 v0 = acc[ai][bj][m][0], v1 = acc[ai][bj][m][1];
                    u32x4 w; w.x = cvt_pk_bf16(v0[0], v0[1]); w.y = cvt_pk_bf16(v0[2], v0[3]); w.z = cvt_pk_bf16(v1[0], v1[1]); w.w = cvt_pk_bf16(v1[2], v1[3]);
                    *(u32x4*)(rowp + bj * HALF) = w; } }
    }
};
struct EpiResF32 {
    static constexpr bool PERM = true, AFTER_DRAIN = false;
    const float* base; float* out; int ldc; float alpha;
    __device__ __forceinline__ void operator()(const f32x4 (&acc)[2][2][4][2], const Unit& u, int wr, int wc, int fr, int fq) const {
        const int row0 = u.pm * BM + wr * 64 + fr; const int col0 = u.pn * BM + wc * 32 + 8 * fq;
#pragma unroll
        for (int ai = 0; ai < 2; ++ai)
#pragma unroll
            for (int m = 0; m < 4; ++m) { const size_t off = (size_t)(row0 + ai * HALF + m * 16) * ldc + col0;
#pragma unroll
                for (int bj = 0; bj < 2; ++bj) {
                    const f32x4 b0 = *(const f32x4*)(base + off + bj * HALF), b1 = *(const f32x4*)(base + off + bj * HALF + 4);
                    *(f32x4*)(out + off + bj * HALF) = b0 * alpha + acc[ai][bj][m][0];
                    *(f32x4*)(out + off + bj * HALF + 4) = b1 * alpha + acc[ai][bj][m][1]; }
                if (m & 1) asm volatile("" ::: "memory"); }
    }
};


template <int CTRL> __device__ __forceinline__ float dppf(float old, float src) {
    return __builtin_bit_cast(float, __builtin_amdgcn_update_dpp(__builtin_bit_cast(int, old), __builtin_bit_cast(int, src), CTRL, 0xf, 0xf, false)); }
struct EpiFfn {
    static constexpr bool PERM = true, AFTER_DRAIN = false;
    bf16_t* act; float* raw; const float* cw; const float* cb; PG8_LAS float* xch; int dff;
    __device__ __forceinline__ void operator()(const f32x4 (&acc)[2][2][4][2], const Unit& u, int wr, int wc, int fr, int fq) const {
        const int upw = 2 * dff;
        if (fr >= 14) {
#pragma unroll
            for (int ai = 0; ai < 2; ++ai)
#pragma unroll
                for (int bj = 0; bj < 2; ++bj)
#pragma unroll
                    for (int n = 0; n < 2; ++n) *(PG8_LAS f32x4*)(xch + ((ai * 2 + wr) * 4 + wc) * 128 + (fr - 14) * 64 + (bj * 2 + n) * 16 + fq * 4) = acc[ai][bj][3][n];
            if (wr == 1) {
#pragma unroll
                for (int bj = 0; bj < 2; ++bj)
#pragma unroll
                    for (int n = 0; n < 2; ++n) *(f32x4*)(raw + ((size_t)u.pm * 4 + 2 + (fr - 14)) * upw + u.pn * BM + bj * HALF + wc * 32 + 8 * fq + 4 * n) = acc[1][bj][3][n];
            }
        }
        if (fr < 2 && wr == 0) {
#pragma unroll
            for (int bj = 0; bj < 2; ++bj)
#pragma unroll
                for (int n = 0; n < 2; ++n) *(f32x4*)(raw + ((size_t)u.pm * 4 + fr) * upw + u.pn * BM + bj * HALF + wc * 32 + 8 * fq + 4 * n) = acc[0][bj][0][n];
        }
        asm volatile("s_waitcnt lgkmcnt(0)" ::: "memory"); __builtin_amdgcn_s_barrier(); asm volatile("" ::: "memory");
        u32x2 keep[2][4];
#pragma unroll
        for (int n = 0; n < 2; ++n) {
            const int ch0 = u.pn * HALF + wc * 32 + 8 * fq + 4 * n;
            f32x4 w0[2], w1[2], w2[2], bb[2];
#pragma unroll
            for (int bj = 0; bj < 2; ++bj) { w0[bj] = *(const f32x4*)(cw + bj * dff + ch0); w1[bj] = *(const f32x4*)(cw + upw + bj * dff + ch0); w2[bj] = *(const f32x4*)(cw + 2 * upw + bj * dff + ch0); bb[bj] = *(const f32x4*)(cb + bj * dff + ch0); }
#pragma unroll
            for (int ai = 0; ai < 2; ++ai) {
                f32x4 h15[2], h14[2];
                if (wr == 1 || ai == 1) { const int src = (wr == 1) ? (ai * 2 + 0) : (0 * 2 + 1);
#pragma unroll
                    for (int bj = 0; bj < 2; ++bj) { h14[bj] = *(const PG8_LAS f32x4*)(xch + (src * 4 + wc) * 128 + 0 * 64 + (bj * 2 + n) * 16 + fq * 4); h15[bj] = *(const PG8_LAS f32x4*)(xch + (src * 4 + wc) * 128 + 1 * 64 + (bj * 2 + n) * 16 + fq * 4); }
                } else {
#pragma unroll
                    for (int bj = 0; bj < 2; ++bj) { h14[bj] = (f32x4){0.f, 0.f, 0.f, 0.f}; h15[bj] = (f32x4){0.f, 0.f, 0.f, 0.f}; } }
#pragma unroll
                for (int m = 0; m < 4; ++m) {
                    float val[2][4];
#pragma unroll
                    for (int bj = 0; bj < 2; ++bj)
#pragma unroll
                        for (int jj = 0; jj < 4; ++jj) {
                            const float cur = acc[ai][bj][m][n][jj];
                            float o1, o2;
                            if (m > 0) { const float pv = acc[ai][bj][m > 0 ? m - 1 : 0][n][jj]; o1 = dppf<0x121>(0.f, pv); o2 = dppf<0x122>(0.f, pv); }
                            else { o1 = h15[bj][jj]; o2 = (fr == 0) ? h14[bj][jj] : h15[bj][jj]; }
                            const float p1 = dppf<0x111>(o1, cur), p2 = dppf<0x112>(o2, cur);
                            val[bj][jj] = w2[bj][jj] * cur + w1[bj][jj] * p1 + w0[bj][jj] * p2 + bb[bj][jj];
                        }
                    float y[4];
#pragma unroll
                    for (int jj = 0; jj < 4; ++jj) { const float g = val[1][jj]; y[jj] = val[0][jj] * g * __builtin_amdgcn_rcpf(1.0f + __builtin_amdgcn_exp2f(-1.4426950408889634f * g)); }
                    u32x2 w; w.x = cvt_pk_bf16(y[0], y[1]); w.y = cvt_pk_bf16(y[2], y[3]);
                    if (n == 0) keep[ai][m] = w;
                    else { const int row = u.pm * BM + ai * HALF + wr * 64 + m * 16 + fr;
                        u32x4 w4; w4.x = keep[ai][m].x; w4.y = keep[ai][m].y; w4.z = w.x; w4.w = w.y;
                        *(u32x4*)(act + (size_t)row * dff + ch0 - 4) = w4; }
                }
            }
        }
    }
};


struct EpiProj {
    static constexpr bool PERM = true, AFTER_DRAIN = false;
    bf16_t* O; int ldc; bf16_t* ymix; float* rawc; float* rawb; const float* cw; PG8_LAS float* xch;
    __device__ __forceinline__ void operator()(const f32x4 (&acc)[2][2][4][2], const Unit& u, int wr, int wc, int fr, int fq) const {
        const int bb = u.pm >> 4, tb0 = (u.pm & 15) * BM + wr * 64 + fr;
        if (u.pn >= 16) {
#pragma unroll
            for (int bj = 0; bj < 2; ++bj) {
                const int hh = 2 * u.pn + bj - 24, ty = hh / 24, g = (hh % 24) >> 3, h = hh & 7;
                bf16_t* plane = O + ((size_t)(((ty * 3 + g) * 8 + bb) * 8 + h) << 19) + wc * 32 + 8 * fq;
#pragma unroll
                for (int ai = 0; ai < 2; ++ai)
#pragma unroll
                    for (int m = 0; m < 4; ++m) { const int t = tb0 + ai * HALF + m * 16; const int ridx = ((t & ((1 << (2 * g)) - 1)) << (12 - 2 * g)) + (t >> (2 * g));
                        const f32x4 v0 = acc[ai][bj][m][0], v1 = acc[ai][bj][m][1];
                        u32x4 w; w.x = cvt_pk_bf16(v0[0], v0[1]); w.y = cvt_pk_bf16(v0[2], v0[3]); w.z = cvt_pk_bf16(v1[0], v1[1]); w.w = cvt_pk_bf16(v1[2], v1[3]);
                        *(u32x4*)(plane + (size_t)ridx * 128) = w; }
            }
            return;
        }
        const int ch0 = u.pn * 64 + wc * 16 + fq * 4;
        if (fr >= 14) {
#pragma unroll
            for (int ai = 0; ai < 2; ++ai) *(PG8_LAS f32x4*)(xch + ((ai * 2 + wr) * 4 + wc) * 32 + (fr - 14) * 16 + fq * 4) = acc[ai][0][3][0] * acc[ai][0][3][1];
            if (wr == 1) *(f32x4*)(rawc + ((size_t)u.pm * 4 + 2 + (fr - 14)) * 1024 + ch0) = acc[1][0][3][0] * acc[1][0][3][1];
        }
        if (fr < 2 && wr == 0) { *(f32x4*)(rawc + ((size_t)u.pm * 4 + fr) * 1024 + ch0) = acc[0][0][0][0] * acc[0][0][0][1]; *(f32x4*)(rawb + ((size_t)u.pm * 2 + fr) * 1024 + ch0) = acc[0][1][0][0]; }
        asm volatile("s_waitcnt lgkmcnt(0)" ::: "memory"); __builtin_amdgcn_s_barrier(); asm volatile("" ::: "memory");
        const f32x4 w0 = *(const f32x4*)(cw + ch0), w1 = *(const f32x4*)(cw + 1024 + ch0), w2 = *(const f32x4*)(cw + 2048 + ch0);
#pragma unroll
        for (int ai = 0; ai < 2; ++ai) {
            f32x4 h15, h14;
            if (wr == 1 || ai == 1) { const int src = (wr == 1) ? (ai * 2 + 0) : (0 * 2 + 1);
                h14 = *(const PG8_LAS f32x4*)(xch + (src * 4 + wc) * 32 + 0 * 16 + fq * 4); h15 = *(const PG8_LAS f32x4*)(xch + (src * 4 + wc) * 32 + 1 * 16 + fq * 4);
            } else { h14 = (f32x4){0.f, 0.f, 0.f, 0.f}; h15 = (f32x4){0.f, 0.f, 0.f, 0.f}; }
            f32x4 prev = (f32x4){0.f, 0.f, 0.f, 0.f};
#pragma unroll
            for (int m = 0; m < 4; ++m) {
                const f32x4 cur = acc[ai][0][m][0] * acc[ai][0][m][1];
                f32x4 y;
#pragma unroll
                for (int jj = 0; jj < 4; ++jj) {
                    float o1, o2;
                    if (m > 0) { o1 = dppf<0x121>(0.f, prev[jj]); o2 = dppf<0x122>(0.f, prev[jj]); }
                    else { o1 = h15[jj]; o2 = (fr == 0) ? h14[jj] : h15[jj]; }
                    const float p1 = dppf<0x111>(o1, cur[jj]), p2 = dppf<0x112>(o2, cur[jj]);
                    y[jj] = acc[ai][1][m][0][jj] * (w2[jj] * cur[jj] + w1[jj] * p1 + w0[jj] * p2);
                }
                prev = cur;
                const size_t row = (size_t)(u.pm * BM + ai * HALF + wr * 64 + m * 16 + fr);
                u32x2 wy; wy.x = cvt_pk_bf16(y[0], y[1]); wy.y = cvt_pk_bf16(y[2], y[3]);
                const f32x4 q = acc[ai][1][m][1];
                u32x2 wq; wq.x = cvt_pk_bf16(q[0], q[1]); wq.y = cvt_pk_bf16(q[2], q[3]);
                const auto s0 = __builtin_amdgcn_permlane16_swap(wy.x, wq.x, false, false); const auto s1 = __builtin_amdgcn_permlane16_swap(wy.y, wq.y, false, false);
                u32x4 w4; w4.x = s0[0]; w4.y = s1[0]; w4.z = s0[1]; w4.w = s1[1];
                bf16_t* dy = ymix + row * 2048 + ch0;
                bf16_t* dq = O + ((size_t)(bb * 8 + (ch0 >> 7)) << 19) + (size_t)(tb0 + ai * HALF + m * 16) * 128 + ((ch0 - 4) & 127);
                *(u32x4*)((fq & 1) ? dq : dy) = w4;
            }
        }
    }
};

template <class Epi, class Sched, bool ALIGN_EPI = false, bool SP2 = false>
__device__ __forceinline__ void gemm_phase(PG8_LAS unsigned char* lds, const Gemm g, const Sched& S, const Epi& E) {
    int tid_l = threadIdx.x; asm volatile("" : "+v"(tid_l));
    const int tid = tid_l, wid = __builtin_amdgcn_readfirstlane(tid >> 6), lane = tid & 63, wr = wid >> 2, wc = wid & 3, fr = lane & 15, fq = lane >> 4;
    const int K = g.K, nt = K / BK;
    unsigned voffA[2], voffB[2];
#pragma unroll
    for (int i = 0; i < 2; ++i) { int R, C; stage_rc(tid * 16 + i * 8192, R, C); const int Rb = Epi::PERM ? ((R & ~31) + perm32(R & 31)) : R;
        voffA[i] = (unsigned)(R * K + C) * 2u; voffB[i] = (unsigned)(Rb * K + C) * 2u; }
    const size_t kstep = (size_t)(BK * 2);
    const size_t hstep = (size_t)HALF * K * 2;
    const size_t tstep = 2 * hstep;
    const unsigned ldsw = (unsigned)wid * 1024u;
    const int aoff = lds_byte(wr * 64 + fr, fq * 8), boff = lds_byte(wc * 32 + fr, fq * 8);
#define PG8_SA(b, h) (((b) * 2 + (h)) * HTB)
#define PG8_SB(b, h) ((4 + (b) * 2 + (h)) * HTB)
#define PG8_STAGE(bufoff, gbase, voff) do { _Pragma("unroll") for (int _i = 0; _i < 2; ++_i) \
        __builtin_amdgcn_global_load_lds((const unsigned*)((const char*)(gbase) + (voff)[_i]), (PG8_LAS unsigned*)(lds + (bufoff) + ldsw + _i * 8192), 16, 0, 0); } while (0)
#define PG8_LDA(dst, b, h) do { _Pragma("unroll") for (int m = 0; m < 4; ++m) _Pragma("unroll") for (int k = 0; k < 2; ++k) dst[m][k] = *(const PG8_LAS bf16x8*)(lds + PG8_SA(b, h) + aoff + m * 2048 + k * 1024); } while (0)
#define PG8_LDB(dst, b, h) do { _Pragma("unroll") for (int n = 0; n < 2; ++n) _Pragma("unroll") for (int k = 0; k < 2; ++k) dst[n][k] = *(const PG8_LAS bf16x8*)(lds + PG8_SB(b, h) + boff + n * 2048 + k * 1024); } while (0)
#define PG8_MMA(ai, bj, At, Bt) do { __builtin_amdgcn_s_setprio(1); _Pragma("unroll") for (int m = 0; m < 4; ++m) _Pragma("unroll") for (int n = 0; n < 2; ++n) _Pragma("unroll") for (int k = 0; k < 2; ++k) \
        acc[ai][bj][m][n] = __builtin_amdgcn_mfma_f32_16x16x32_bf16(Bt[n][k], At[m][k], acc[ai][bj][m][n], 0, 0, 0); __builtin_amdgcn_s_setprio(0); } while (0)
#define PG8_WAIT_V(n) asm volatile("s_waitcnt vmcnt(" #n ")" ::: "memory")
#define PG8_WAIT_L(n) asm volatile("s_waitcnt lgkmcnt(" #n ")" ::: "memory")
#define PG8_BAR __builtin_amdgcn_s_barrier()
#define PG8_SCHED __builtin_amdgcn_sched_barrier(0)
    Unit cur, nxt; int ui = 0;
    if (!S.next(0, cur)) return;
    f32x4 acc[2][2][4][2];
#pragma unroll
    for (int a = 0; a < 2; ++a)
#pragma unroll
        for (int b = 0; b < 2; ++b)
#pragma unroll
            for (int m = 0; m < 4; ++m)
#pragma unroll
                for (int n = 0; n < 2; ++n) acc[a][b][m][n] = (f32x4){0.f, 0.f, 0.f, 0.f};
    bf16x8 At[4][2], B0[2][2], B1[2][2];
    const char* cA = (const char*)g.A + (size_t)cur.pm * tstep; const char* cB = (const char*)g.Bt + (size_t)cur.pn * tstep;
    S.a_ready(cur);
    if constexpr (SP2) {
        PG8_STAGE(PG8_SB(0, 0), cB, voffB); PG8_STAGE(PG8_SB(0, 1), cB + hstep, voffB); PG8_STAGE(PG8_SA(0, 0), cA, voffA); PG8_STAGE(PG8_SA(0, 1), cA + hstep, voffA);
        if (wr == 1) PG8_BAR;
        PG8_WAIT_V(2); PG8_BAR;
        PG8_STAGE(PG8_SB(1, 0), cB + kstep, voffB); PG8_STAGE(PG8_SA(1, 0), cA + kstep, voffA); PG8_STAGE(PG8_SB(1, 1), cB + hstep + kstep, voffB);
        PG8_WAIT_V(6); PG8_BAR;
    } else {
        PG8_STAGE(PG8_SB(0, 0), cB, voffB); PG8_STAGE(PG8_SA(0, 0), cA, voffA); PG8_STAGE(PG8_SB(0, 1), cB + hstep, voffB); PG8_STAGE(PG8_SA(0, 1), cA + hstep, voffA);
        if (wr == 1) PG8_BAR;
        PG8_WAIT_V(4); PG8_BAR;
        PG8_STAGE(PG8_SB(1, 0), cB + kstep, voffB); PG8_STAGE(PG8_SA(1, 0), cA + kstep, voffA); PG8_STAGE(PG8_SB(1, 1), cB + hstep + kstep, voffB);
        PG8_WAIT_V(6); PG8_BAR;
    }
    for (;;) {
        const bool has_next = S.next(ui + 1, nxt);
        const char* nA = has_next ? (const char*)g.A + (size_t)nxt.pm * tstep : cA; const char* nB = has_next ? (const char*)g.Bt + (size_t)nxt.pn * tstep : cB;
        for (int t = 0; t < nt; t += 2) {
            const bool last = (t == nt - 2);
            const char* a1 = cA + (size_t)(t + 1) * kstep;
            const char* a2 = last ? nA : cA + (size_t)(t + 2) * kstep; const char* b2 = last ? nB : cB + (size_t)(t + 2) * kstep;
            const char* a3 = a2 + kstep; const char* b3 = b2 + kstep;
            if (last && has_next) S.a_ready(nxt);
            if constexpr (SP2) {
            PG8_LDB(B0, 0, 0); PG8_LDB(B1, 0, 1); PG8_SCHED; PG8_LDA(At, 0, 0); PG8_STAGE(PG8_SA(1, 1), a1 + hstep, voffA);
            PG8_WAIT_V(8); PG8_WAIT_L(0); PG8_BAR; PG8_MMA(0, 0, At, B0); PG8_MMA(0, 1, At, B1); PG8_BAR; PG8_SCHED;
            PG8_LDA(At, 0, 1); PG8_STAGE(PG8_SB(0, 0), b2, voffB); PG8_STAGE(PG8_SB(0, 1), b2 + hstep, voffB); PG8_STAGE(PG8_SA(0, 0), a2, voffA);
            PG8_WAIT_V(8); PG8_WAIT_L(0); PG8_BAR; PG8_MMA(1, 0, At, B0); PG8_MMA(1, 1, At, B1); PG8_BAR; PG8_SCHED;
            PG8_LDB(B0, 1, 0); PG8_LDB(B1, 1, 1); PG8_SCHED; PG8_LDA(At, 1, 0); PG8_STAGE(PG8_SA(0, 1), a2 + hstep, voffA);
            PG8_WAIT_V(8); PG8_WAIT_L(0); PG8_BAR; PG8_MMA(0, 0, At, B0); PG8_MMA(0, 1, At, B1); PG8_BAR; PG8_SCHED;
            PG8_LDA(At, 1, 1); PG8_STAGE(PG8_SB(1, 0), b3, voffB); PG8_STAGE(PG8_SB(1, 1), b3 + hstep, voffB); PG8_STAGE(PG8_SA(1, 0), a3, voffA);
            PG8_WAIT_V(8); PG8_WAIT_L(0); PG8_BAR; PG8_MMA(1, 0, At, B0); PG8_MMA(1, 1, At, B1); PG8_BAR; PG8_SCHED;
            } else {
            PG8_LDB(B0, 0, 0); PG8_SCHED; PG8_LDA(At, 0, 0); PG8_STAGE(PG8_SA(1, 1), a1 + hstep, voffA);
            PG8_WAIT_L(8); PG8_BAR; PG8_WAIT_L(0); PG8_MMA(0, 0, At, B0); PG8_BAR; PG8_SCHED;
            PG8_LDB(B1, 0, 1); PG8_STAGE(PG8_SB(0, 0), b2, voffB);
            PG8_BAR; PG8_WAIT_L(0); PG8_MMA(0, 1, At, B1); PG8_BAR;
            PG8_LDA(At, 0, 1); PG8_STAGE(PG8_SA(0, 0), a2, voffA);
            PG8_BAR; PG8_WAIT_L(0); PG8_MMA(1, 0, At, B0); PG8_BAR; PG8_SCHED;
            PG8_STAGE(PG8_SB(0, 1), b2 + hstep, voffB);
            PG8_WAIT_V(6); PG8_BAR; PG8_MMA(1, 1, At, B1); PG8_BAR;
            PG8_LDB(B0, 1, 0); PG8_SCHED; PG8_LDA(At, 1, 0); PG8_STAGE(PG8_SA(0, 1), a2 + hstep, voffA);
            PG8_WAIT_L(8); PG8_BAR; PG8_WAIT_L(0); PG8_MMA(0, 0, At, B0); PG8_BAR; PG8_SCHED;
            PG8_LDB(B1, 1, 1); PG8_STAGE(PG8_SB(1, 0), b3, voffB);
            PG8_BAR; PG8_WAIT_L(0); PG8_MMA(0, 1, At, B1); PG8_BAR;
            PG8_LDA(At, 1, 1); PG8_STAGE(PG8_SA(1, 0), a3, voffA);
            PG8_BAR; PG8_WAIT_L(0); PG8_MMA(1, 0, At, B0); PG8_BAR; PG8_SCHED;
            PG8_STAGE(PG8_SB(1, 1), b3 + hstep, voffB);
            PG8_WAIT_V(6); PG8_BAR; PG8_MMA(1, 1, At, B1); PG8_BAR;
            }
        }
        if constexpr (ALIGN_EPI) { if (wr == 0) PG8_BAR; }
        if constexpr (!Epi::AFTER_DRAIN) { E(acc, cur, wr, wc, fr, fq); S.done(cur); }
        if (!has_next) break;
#pragma unroll
        for (int a = 0; a < 2; ++a)
#pragma unroll
            for (int b = 0; b < 2; ++b)
#pragma unroll
                for (int m = 0; m < 4; ++m)
#pragma unroll
                    for (int n = 0; n < 2; ++n) acc[a][b][m][n] = (f32x4){0.f, 0.f, 0.f, 0.f};
        cur = nxt; cA = nA; cB = nB; ++ui;
        if constexpr (ALIGN_EPI) { if (wr == 1) PG8_BAR; }
    }
    PG8_WAIT_V(0);
    if constexpr (!ALIGN_EPI) { if (wr == 0) PG8_BAR; }
    PG8_BAR;
    if constexpr (Epi::AFTER_DRAIN) { E.fused(acc, cur, wr, wc, fr, fq, lds, wid, lane); S.done(cur); }
#undef PG8_SA
#undef PG8_SB
#undef PG8_STAGE
#undef PG8_LDA
#undef PG8_LDB
#undef PG8_MMA
#undef PG8_WAIT_V
#undef PG8_WAIT_L
#undef PG8_BAR
#undef PG8_SCHED
}
}
constexpr int DM = 2048, BATCH = 8, SEQ = 4096, MTOK = BATCH * SEQ;
constexpr int CONVW = 1024, QKVW = 3072, PROJW = 12288, DFF = 5632, UPW = 2 * DFF;
constexpr int QOFF = 3 * CONVW, KOFF = QOFF + QKVW, VOFF = KOFF + QKVW;
constexpr float ALPHA = 1.189207115002721f;
constexpr float LN_EPS = 1e-5f;
constexpr int NWAVES = 8, NTHREADS = 512;
constexpr int HALF_TOK = MTOK / 2;

constexpr size_t MiB = 1u << 20;
constexpr size_t WS_WIN = 2 * MiB, WS_WOUT = 50 * MiB, WS_WUP = 58 * MiB, WS_WDN = 102 * MiB;
constexpr size_t WS_XB = 124 * MiB;
constexpr size_t WS_OG0 = 124 * MiB, WS_OG1 = 188 * MiB, WS_HB = 124 * MiB;
constexpr size_t WS_PROJ = 252 * MiB;
constexpr size_t WS_MIXB = 252 * MiB;
constexpr size_t WS_HF = 380 * MiB;
constexpr size_t WS_ACT = 636 * MiB;
constexpr size_t WS_RAW = 988 * MiB;
constexpr size_t WS_LSE = 1020 * MiB;
constexpr size_t WS_BIAS2 = 1023 * MiB;
constexpr size_t WS_BAR = 0;
constexpr size_t WS_END = 1024 * MiB;
constexpr size_t OUT_YMIX = 0, OUT_OG2 = 128 * MiB, OUT_RAWC = 192 * MiB, OUT_RAWB = 194 * MiB;

constexpr int LDS_BYTES = 147456;
constexpr int LDS_TAB = 131072;
constexpr int LDS_XCH = 131072 + 1024;
constexpr int LDS_MISC = 131072 + 1024 + 8192;

#define GAS __attribute__((address_space(1)))
#define LAS __attribute__((address_space(3)))
typedef unsigned short bf16;
typedef unsigned v4u __attribute__((ext_vector_type(4)));
typedef unsigned v2u __attribute__((ext_vector_type(2)));
typedef float f32x4 __attribute__((ext_vector_type(4)));
typedef short bf16x8 __attribute__((ext_vector_type(8)));
typedef short s16x4 __attribute__((ext_vector_type(4)));
#define LDS_WAIT() asm volatile("s_waitcnt lgkmcnt(0)" ::: "memory")

__device__ __forceinline__ unsigned f2bf(float f) { unsigned u = __builtin_bit_cast(unsigned, f); return (u + 0x7fffu + ((u >> 16) & 1u)) >> 16; }
__device__ __forceinline__ unsigned pk2(float lo, float hi) { return f2bf(lo) | (f2bf(hi) << 16); }
typedef float f32x2_t __attribute__((ext_vector_type(2))); typedef __bf16 bf16x2_t __attribute__((ext_vector_type(2)));
__device__ __forceinline__ unsigned cvtpk(float lo, float hi) { f32x2_t v = {lo, hi}; bf16x2_t b = __builtin_convertvector(v, bf16x2_t); return __builtin_bit_cast(unsigned, b); }
__device__ __forceinline__ float bflo(unsigned w) { return __builtin_bit_cast(float, w << 16); }
__device__ __forceinline__ float bfhi(unsigned w) { return __builtin_bit_cast(float, w & 0xffff0000u); }

__device__ const unsigned char BUCKET_TAB[3][132] = {
 {0,1,2,3,4,5,6,7,8,9,10,11,12,13,14,15,16,16,16,16,16,16,17,17,17,17,17,17,17,17,18,18,18,18,18,18,18,18,18,18,19,19,19,19,19,19,19,19,19,19,19,19,19,19,20,20,20,20,20,20,20,20,20,20,20,20,20,20,20,20,20,20,20,21,21,21,21,21,21,21,21,21,21,21,21,21,21,21,21,21,21,21,21,21,21,21,21,21,21,22,22,22,22,22,22,22,22,22,22,22,22,22,22,22,22,22,22,22,22,22,22,22,22,22,22,22,22,22,22,0,0,0},
 {0,4,8,12,16,16,17,17,18,18,19,19,19,19,20,20,20,20,20,21,21,21,21,21,21,22,22,22,22,22,22,22,22,22,23,23,23,23,23,23,23,23,23,23,23,23,24,24,24,24,24,24,24,24,24,24,24,24,24,24,24,24,25,25,25,25,25,25,25,25,25,25,25,25,25,25,25,25,25,25,25,25,25,26,26,26,26,26,26,26,26,26,26,26,26,26,26,26,26,26,26,26,26,26,26,26,26,26,26,26,26,26,26,27,27,27,27,27,27,27,27,27,27,27,27,27,27,27,27,0,0,0},
 {0,16,18,19,20,21,21,22,22,23,23,23,24,24,24,24,25,25,25,25,25,26,26,26,26,26,26,26,26,27,27,27,27,27,27,27,27,27,27,28,28,28,28,28,28,28,28,28,28,28,28,28,29,29,29,29,29,29,29,29,29,29,29,29,29,29,29,29,29,29,30,30,30,30,30,30,30,30,30,30,30,30,30,30,30,30,30,30,30,30,30,30,30,30,30,31,31,31,31,31,31,31,31,31,31,31,31,31,31,31,31,31,31,31,31,31,31,31,31,31,31,31,31,31,31,31,31,31,31,0,0,0}};

__device__ __forceinline__ int mixdest(int sc) {
    if (sc >= 4096) return sc;
    const int stream = sc >> 10, ch = sc & 1023, mu = ch >> 6, r = ch & 63;
    const int base = 256 * mu + 32 * (r >> 4) + 8 * ((r >> 2) & 3) + (r & 3);
    return base + (stream == 0 ? 0 : stream == 2 ? 4 : stream == 1 ? 128 : 132);
}
template <int MODE  > __device__ __forceinline__ void p0_transpose_item(const float* W, int K, int N, bf16* WT, LAS float* scr, int item, int lane) {
    const int nblk = N / 32, kb = item / nblk, nb = item % nblk, k0 = 64 * kb, n0 = 32 * nb;
    int d0 = n0;
    if (MODE == 1) { d0 = n0 < DFF ? 256 * (n0 / 128) + (n0 % 128) : 256 * ((n0 - DFF) / 128) + 128 + ((n0 - DFF) % 128); }
#pragma unroll 8
    for (int i = 0; i < 32; ++i) { const int kk = 2 * i + (lane >> 5); scr[kk * 33 + (lane & 31)] = W[(size_t)(k0 + kk) * N + n0 + (lane & 31)]; }
    LDS_WAIT(); asm volatile("" ::: "memory");
    const int c = lane & 7;
#pragma unroll
    for (int j = 0; j < 4; ++j) { const int n = (lane >> 3) + 8 * j; const LAS float* s = scr + (8 * c) * 33 + n;
        v4u o; o.x = pk2(s[0 * 33], s[1 * 33]); o.y = pk2(s[2 * 33], s[3 * 33]); o.z = pk2(s[4 * 33], s[5 * 33]); o.w = pk2(s[6 * 33], s[7 * 33]);
        const int drow = (MODE == 2) ? mixdest(n0 + n) : d0 + n;
        *(v4u*)(WT + (size_t)drow * K + k0 + 8 * c) = o; }
    LDS_WAIT(); asm volatile("" ::: "memory");
}
__device__ __forceinline__ float wave_sum(float v) {
#pragma unroll
    for (int o = 1; o < 64; o <<= 1) v += __shfl_xor(v, o);
    return v;
}

#define RLX_AGENT __ATOMIC_RELAXED, __HIP_MEMORY_SCOPE_AGENT
#define XB_TMO      128
#define XB_XCNT(j)  (256  + 64 * (j))
#define XB_XSUB(j)  (1280 + 64 * (j))
#define XB_XGEN(j)  (2304 + 64 * (j))
#define XB_TOP      3328
#define XB_TOPGEN   3392
#define XCD_BAR_WORDS 3456
#define XB_SPIN_CAP (1u << 18)

__device__ __forceinline__ unsigned xb_ld(unsigned* p)              { return __hip_atomic_load(p, __ATOMIC_RELAXED, __HIP_MEMORY_SCOPE_AGENT); }
__device__ __forceinline__ unsigned xb_add(unsigned* p, unsigned v) { return __hip_atomic_fetch_add(p, v, __ATOMIC_RELAXED, __HIP_MEMORY_SCOPE_AGENT); }
__device__ __forceinline__ unsigned xb_xcc_id() { return (unsigned)__builtin_amdgcn_s_getreg((3 << 11) | 20) & 0xFu; }
#define XB_SPIN(cond, bar) do { unsigned _sp = 0; while (cond) { __builtin_amdgcn_s_sleep(1); \
    if ((++_sp & 255u) == 0u) { if (xb_ld(&(bar)[XB_TMO])) break; if (_sp > XB_SPIN_CAP) { atomicAdd(&(bar)[XB_TMO], 1u); break; } } } } while (0)

struct XcdBarrier {
    unsigned* bar; unsigned x;
    volatile LAS unsigned* st;
};

__device__ __forceinline__ XcdBarrier xcd_barrier_post(unsigned* bar, volatile LAS unsigned* st) {
    XcdBarrier b; b.bar = bar; b.x = xb_xcc_id(); b.st = st;
    if (threadIdx.x == 0) (void)xb_add(&bar[XB_XCNT(b.x)], 1u);
    return b;
}
__device__ __forceinline__ void xcd_barrier_complete(unsigned* bar, unsigned x, unsigned& nloc, unsigned& nx) {
    const unsigned G = gridDim.x * gridDim.y * gridDim.z;
    unsigned sum, cnt, mine, sp = 0u;
    for (;;) {
        sum = 0u; cnt = 0u; mine = 0u;
#pragma unroll
        for (unsigned j = 0; j < 16; ++j) { const unsigned c = xb_ld(&bar[XB_XCNT(j)]); sum += c; cnt += (c > 0u) ? 1u : 0u; mine = (j == x) ? c : mine; }
        if (sum == G) break;
        __builtin_amdgcn_s_sleep(1);
        if ((++sp & 255u) == 0u) { if (xb_ld(&bar[XB_TMO])) break; if (sp > XB_SPIN_CAP) { atomicAdd(&bar[XB_TMO], 1u); break; } }
    }
    nloc = mine > 0u ? mine : 1u; nx = cnt > 0u ? cnt : 1u;
}

__device__ __forceinline__ void xcd_barrier(const XcdBarrier& b) {
    asm volatile("s_waitcnt vmcnt(0)" ::: "memory");
    __syncthreads();
    if (threadIdx.x == 0) {
        unsigned* bar = b.bar;
        __builtin_amdgcn_s_waitcnt(0);
        unsigned nloc = b.st[0], nx = b.st[1];
        if (nloc == 0u) { xcd_barrier_complete(bar, b.x, nloc, nx); b.st[0] = nloc; b.st[1] = nx; }
        const unsigned old = xb_add(&bar[XB_XSUB(b.x)], 1u);
        const unsigned gen = old / nloc;
        if (old + 1u == (gen + 1u) * nloc) {
            __builtin_amdgcn_fence(__ATOMIC_RELEASE, "agent");
            asm volatile("s_waitcnt vmcnt(0)" ::: "memory");
            const unsigned og = xb_add(&bar[XB_TOP], 1u);
            const unsigned tg = og / nx;
            if (og + 1u == (tg + 1u) * nx) xb_add(&bar[XB_TOPGEN], 1u);
            else XB_SPIN(xb_ld(&bar[XB_TOPGEN]) == tg, bar);
            __builtin_amdgcn_fence(__ATOMIC_ACQUIRE, "agent");
            xb_add(&bar[XB_XGEN(b.x)], 1u);
            asm volatile("s_waitcnt vmcnt(0)" ::: "memory");
        } else {
            XB_SPIN(xb_ld(&bar[XB_XGEN(b.x)]) == gen, bar);
            __builtin_amdgcn_fence(__ATOMIC_ACQUIRE, "agent");
            asm volatile("s_waitcnt vmcnt(0)" ::: "memory");
        }
    }
    __syncthreads();
}

__device__ __forceinline__ unsigned off_b(unsigned row, unsigned ch) { return 256u * row + 16u * (ch ^ (((row & 3) << 2) | ((row >> 2) & 3))); }
__device__ __forceinline__ s16x4 vtr(unsigned lds_addr) {
    return __builtin_bit_cast(s16x4, __builtin_amdgcn_ds_read_tr16_b64_v4i16((LAS s16x4*)(uintptr_t)lds_addr)); }

struct AttnUnit { int b, g, h, r, n; };
struct AttnRegs { v4u kr[4], vr[4]; bf16x8 qf[4]; float tabv; };
__device__ __forceinline__ AttnUnit attn_decode(int uid) {
    AttnUnit u; const int rn = uid & 31; u.h = (uid >> 5) & 7; const int bg = uid >> 8; u.g = bg % 3; u.b = bg / 3;
    const int nb = 32 >> (2 * u.g); u.r = rn / nb; u.n = rn % nb; return u; }
__device__ __forceinline__ const bf16* attn_plane(const bf16* qkv, int ty, const AttnUnit& u) { return qkv + ((size_t)(((ty * 3 + u.g) * 8 + u.b) * 8 + u.h) << 19); }
__device__ __forceinline__ void attn_issue(AttnRegs& R, const AttnUnit& u, int blk, bool with_q, const bf16* qkv, const float* bias2) {
    const int tid = threadIdx.x, lane = tid & 63, w = tid >> 6;
    const int L = 4096 >> (2 * u.g), gh = u.g * 8 + u.h;
    const int ch = tid & 15, r0 = tid >> 4;
    if (with_q) R.tabv = bias2[gh * 192 + (tid < 192 ? tid : 0)];
    const size_t rb = (size_t)(u.r * L + blk * 128 + r0) * 128 + ch * 8;
    const bf16* kp = attn_plane(qkv, 1, u) + rb; const bf16* vp = attn_plane(qkv, 2, u) + rb;
#pragma unroll
    for (int j = 0; j < 4; ++j) { R.kr[j] = *(const v4u*)(kp + (size_t)j * 32 * 128); R.vr[j] = *(const v4u*)(vp + (size_t)j * 32 * 128); }
    if (with_q) {
        const int qi = 16 * w + (lane & 15), kg = lane >> 4;
        const bf16* qp = attn_plane(qkv, 0, u) + (size_t)(u.r * L + u.n * 128 + qi) * 128 + 8 * kg;
#pragma unroll
        for (int s = 0; s < 4; ++s) R.qf[s] = *(const bf16x8*)(qp + 32 * s);
    }
}
__device__ __forceinline__ void attn_commit(const AttnRegs& R, int blk, bool with_tab, LAS unsigned char* lds) {
    const int tid = threadIdx.x; const int ch = tid & 15, r0 = tid >> 4;
    LAS unsigned char* Ks = lds; LAS unsigned char* Vs = lds + 65536; LAS float* tab = (LAS float*)(lds + LDS_TAB);
#pragma unroll
    for (int j = 0; j < 4; ++j) { const unsigned row = (blk & 1) * 128 + r0 + 32 * j; *(LAS v4u*)(Ks + off_b(row, ch)) = R.kr[j]; *(LAS v4u*)(Vs + off_b(row, ch)) = R.vr[j]; }
    if (with_tab && tid < 192) tab[tid] = R.tabv;
}
__device__ __forceinline__ void attn_compute(LAS unsigned char* lds, const bf16x8 (&qf)[4], const AttnUnit& u, bf16* og, float* lse) {
    const int tid = threadIdx.x, lane = tid & 63, w = __builtin_amdgcn_readfirstlane(tid >> 6);
    const int d = 1 << (2 * u.g); const int n = u.n, h = u.h;
    const unsigned par = (unsigned)((n + 1) & 1) << 15;
    LAS unsigned char* Ks = lds; LAS unsigned char* Vs = lds + 65536; LAS float* tab = (LAS float*)(lds + LDS_TAB);
    const int qi = 16 * w + (lane & 15), kg = lane >> 4;
    const size_t qtok = (size_t)u.b * SEQ + (size_t)(n * 128 + qi) * d + u.r;
    const int ks0 = w >> 1;
    const int i15 = lane & 15;
    f32x4 sc[5][2];
    const unsigned krow = 8 * (i15 >> 2) + (i15 & 3);
#pragma unroll
    for (int kk = 0; kk < 5; ++kk) {
        const int ks = ks0 + kk;
        bf16x8 kf[2][4];
#pragma unroll
        for (int T = 0; T < 2; ++T)
#pragma unroll
            for (int s = 0; s < 4; ++s) kf[T][s] = *(const LAS bf16x8*)(Ks + (off_b(32 * ks + krow + 4 * T, 4 * s + kg) ^ par));
#pragma unroll
        for (int T = 0; T < 2; ++T) {
            f32x4 a = {0.f, 0.f, 0.f, 0.f};
#pragma unroll
            for (int s = 0; s < 4; ++s) a = __builtin_amdgcn_mfma_f32_16x16x32_bf16(kf[T][s], qf[s], a, 0, 0, 0);
            sc[kk][T] = a;
        }
    }
    float tb[5][2][4];
    { const LAS float* tp = tab + (31 - 16 * (w & 1) - i15 + 8 * kg);
#pragma unroll
      for (int kk = 0; kk < 5; ++kk)
#pragma unroll
          for (int T = 0; T < 2; ++T)
#pragma unroll
              for (int jj = 0; jj < 4; ++jj) tb[kk][T][jj] = tp[32 * kk + 4 * T + jj]; }
    const float SCL = 0.08838834764831845f * 1.4426950408889634f;
    float mx = -1e30f;
#pragma unroll
    for (int kk = 0; kk < 5; ++kk) {
        const bool dead = (n == 0) && (ks0 + kk < 4);
#pragma unroll
        for (int T = 0; T < 2; ++T)
#pragma unroll
            for (int jj = 0; jj < 4; ++jj) { float v = sc[kk][T][jj] * SCL + tb[kk][T][jj]; v = dead ? -1e30f : v; sc[kk][T][jj] = v; mx = fmaxf(mx, v); }
    }
    mx = fmaxf(mx, __shfl_xor(mx, 16)); mx = fmaxf(mx, __shfl_xor(mx, 32));
    float l = 0.f;
    bf16x8 pf[5];
#pragma unroll
    for (int kk = 0; kk < 5; ++kk) {
        float e[8];
#pragma unroll
        for (int T = 0; T < 2; ++T)
#pragma unroll
            for (int jj = 0; jj < 4; ++jj) { const float p = __builtin_amdgcn_exp2f(sc[kk][T][jj] - mx); e[4 * T + jj] = p; l += p; }
        v4u pw; pw.x = cvtpk(e[0], e[1]); pw.y = cvtpk(e[2], e[3]); pw.z = cvtpk(e[4], e[5]); pw.w = cvtpk(e[6], e[7]);
        pf[kk] = __builtin_bit_cast(bf16x8, pw);
    }
    l += __shfl_xor(l, 16); l += __shfl_xor(l, 32);
    f32x4 o[8];
#pragma unroll
    for (int c = 0; c < 8; ++c) o[c] = (f32x4){0.f, 0.f, 0.f, 0.f};
    const unsigned vbase = (unsigned)(uintptr_t)Vs;
    const unsigned q4 = (lane & 15) >> 2, p4 = lane & 3;
    s16x4 vlo[2][8], vhi[2][8];
#define ATT_VLOAD(kk_, buf_) do { const unsigned r0_ = 32 * (ks0 + (kk_)) + 8 * kg + q4; _Pragma("unroll") for (int c = 0; c < 8; ++c) { \
        vlo[buf_][c] = vtr(vbase + ((off_b(r0_, 2 * c + (p4 >> 1)) + 8 * (p4 & 1)) ^ par)); vhi[buf_][c] = vtr(vbase + ((off_b(r0_ + 4, 2 * c + (p4 >> 1)) + 8 * (p4 & 1)) ^ par)); } } while (0)
    ATT_VLOAD(0, 0);
#pragma unroll
    for (int kk = 0; kk < 5; ++kk) {
        if (kk < 4) ATT_VLOAD(kk + 1, (kk + 1) & 1);
#pragma unroll
        for (int c = 0; c < 8; ++c) {
            const s16x4 lo = vlo[kk & 1][c], hi = vhi[kk & 1][c];
            const bf16x8 vf = (bf16x8){lo[0], lo[1], lo[2], lo[3], hi[0], hi[1], hi[2], hi[3]};
            o[c] = __builtin_amdgcn_mfma_f32_16x16x32_bf16(vf, pf[kk], o[c], 0, 0, 0);
        }
    }
#undef ATT_VLOAD
    const float rl = 1.0f / l;
    bf16* op = og + qtok * 1024 + h * 128 + 4 * kg;
#pragma unroll
    for (int c = 0; c < 8; ++c) { v2u wv; wv.x = cvtpk(o[c][0] * rl, o[c][1] * rl); wv.y = cvtpk(o[c][2] * rl, o[c][3] * rl); *(v2u*)(op + 16 * c) = wv; }
    if (kg == 0) lse[qtok * 8 + h] = mx + __builtin_amdgcn_logf(l);
}

struct Args { const float* in[13]; float* out; unsigned char* ws; };
__global__ void __launch_bounds__(NTHREADS, 2) fwd_megakernel(Args args) {
    extern __shared__ __attribute__((aligned(16))) unsigned char lds_raw[];
    LAS unsigned char* lds = (LAS unsigned char*)lds_raw;
    cg::grid_group grid = cg::this_grid();
    const int G = gridDim.x, bx = blockIdx.x;
    const int vcu = (G % 8 == 0) ? (bx % 8) * (G / 8) + bx / 8 : bx;
    unsigned char* ws = args.ws; unsigned char* outb = (unsigned char*)args.out;
    const float* x = args.in[0]; const float* w_in = args.in[1]; const float* conv_mix_w = args.in[2]; const float* w_out = args.in[3];
    const float* ln1_g = args.in[4]; const float* ln1_b = args.in[5]; const float* w_up = args.in[6]; const float* ffn_conv_w = args.in[7];
    const float* ffn_conv_b = args.in[8]; const float* w_down = args.in[9]; const float* ln2_g = args.in[10]; const float* ln2_b = args.in[11];
    const float* rel_bias = args.in[12];
    bf16* WIN = (bf16*)(ws + WS_WIN); bf16* WOUT = (bf16*)(ws + WS_WOUT); bf16* WUP = (bf16*)(ws + WS_WUP); bf16* WDN = (bf16*)(ws + WS_WDN);
    bf16* XB = (bf16*)(ws + WS_XB); bf16* PROJ = (bf16*)(ws + WS_PROJ); float* HF = (float*)(ws + WS_HF); bf16* MIXB = (bf16*)(ws + WS_MIXB); bf16* HB = (bf16*)(ws + WS_HB);
    bf16* ACT = (bf16*)(ws + WS_ACT); float* RAW = (float*)(ws + WS_RAW); float* LSE = (float*)(ws + WS_LSE); float* BIAS2 = (float*)(ws + WS_BIAS2);
    bf16* OG0 = (bf16*)(ws + WS_OG0); bf16* OG1 = (bf16*)(ws + WS_OG1); bf16* OG2 = (bf16*)(outb + OUT_OG2);
    bf16* YMIX = (bf16*)(outb + OUT_YMIX); float* RAWC = (float*)(outb + OUT_RAWC); float* RAWB = (float*)(outb + OUT_RAWB);
#define PHASE_IDS() int tid_p = threadIdx.x; asm volatile("" : "+v"(tid_p)); const int lane = tid_p & 63; const int wave_p = __builtin_amdgcn_readfirstlane(tid_p >> 6); \
    const int gw = vcu * NWAVES + wave_p, NGW = G * NWAVES; const size_t gt = (size_t)bx * NTHREADS + tid_p, NGT = (size_t)G * NTHREADS; (void)lane; (void)gw; (void)NGW; (void)gt; (void)NGT

    unsigned* barw = (unsigned*)(ws + WS_BAR);
    volatile LAS unsigned* misc = (volatile LAS unsigned*)(lds + LDS_MISC);
    if (threadIdx.x < 2) misc[threadIdx.x] = 0u;
    if (bx == 0) { for (int i = threadIdx.x; i < XCD_BAR_WORDS; i += NTHREADS) barw[i] = 0u; }
    {
        PHASE_IDS();
        LAS float* scr = (LAS float*)(lds + wave_p * 16384);
        constexpr int I_IN = (DM / 64) * (PROJW / 32), I_OUT = (DM / 64) * (DM / 32), I_UP = (DM / 64) * (UPW / 32), I_DN = (DFF / 64) * (DM / 32);
        constexpr int NITEMS = I_IN + I_OUT + I_UP + I_DN;
        for (int it = gw; it < NITEMS; it += NGW) {
            int r = it;
            if (r < I_IN) { p0_transpose_item<2>(w_in, DM, PROJW, WIN, scr, r, lane); continue; } r -= I_IN;
            if (r < I_OUT) { p0_transpose_item<0>(w_out, DM, DM, WOUT, scr, r, lane); continue; } r -= I_OUT;
            if (r < I_UP) { p0_transpose_item<1>(w_up, DM, UPW, WUP, scr, r, lane); continue; } r -= I_UP;
            p0_transpose_item<0>(w_down, DFF, DM, WDN, scr, r, lane);
        }
        if (gt < 24 * 192) { const int gh = (int)gt / 192, j = (int)gt % 192, steps = 159 - j;
            BIAS2[gt] = (steps >= 0 && steps <= 128) ? rel_bias[(int)BUCKET_TAB[gh >> 3][steps] * 24 + gh] * 1.4426950408889634f : -1e30f; }
        const size_t n8 = (size_t)MTOK * DM / 8;
        for (size_t i = gt; i < n8; i += NGT) { const f32x4 a = *(const f32x4*)(x + i * 8), c = *(const f32x4*)(x + i * 8 + 4);
            v4u o; o.x = cvtpk(a[0], a[1]); o.y = cvtpk(a[2], a[3]); o.z = cvtpk(c[0], c[1]); o.w = cvtpk(c[2], c[3]); *(v4u*)(XB + i * 8) = o; }
    }
    grid.sync();
    const XcdBarrier xbar = xcd_barrier_post(barw, misc);
    {
        pg8::Gemm g{XB, WIN, MTOK, PROJW, DM}; pg8::StaticOrder S; S.init(MTOK, PROJW, G, bx);
        pg8::EpiProj E{PROJ, PROJW, YMIX, RAWC, RAWB, conv_mix_w, (LAS float*)(lds + LDS_XCH)};
        pg8::gemm_phase<pg8::EpiProj, pg8::StaticOrder, true, true>(lds, g, S, E);
    }
    xcd_barrier(xbar);
    {
        constexpr int NUNITS = BATCH * 3 * 8 * 32;
        const int per = (NUNITS + G - 1) / G;
        const int u0 = vcu * per, u1 = (u0 + per < NUNITS) ? u0 + per : NUNITS;
        { const v4u z = {0u, 0u, 0u, 0u}; for (int i = threadIdx.x; i < 8192; i += NTHREADS) *(LAS v4u*)(lds + 16 * i) = z; }
        asm volatile("s_waitcnt lgkmcnt(0)" ::: "memory"); __builtin_amdgcn_s_barrier(); asm volatile("" ::: "memory");
        AttnRegs R;
        if (u0 < u1) { const AttnUnit un = attn_decode(u0);
            if (un.n > 0) { attn_issue(R, un, un.n - 1, false, PROJ, BIAS2); attn_commit(R, un.n - 1, false, lds); }
            attn_issue(R, un, un.n, true, PROJ, BIAS2); }
        for (int uid = u0; uid < u1; ++uid) {
            const AttnUnit u = attn_decode(uid);
            attn_commit(R, u.n, true, lds);
            bf16x8 qf[4];
#pragma unroll
            for (int s4 = 0; s4 < 4; ++s4) qf[s4] = R.qf[s4];
            asm volatile("s_waitcnt lgkmcnt(0)" ::: "memory"); __builtin_amdgcn_s_barrier(); asm volatile("" ::: "memory");
            if (uid + 1 < u1) { const AttnUnit un = attn_decode(uid + 1); attn_issue(R, un, un.n, true, PROJ, BIAS2); }
            bf16* og = u.g == 0 ? OG0 : (u.g == 1 ? OG1 : OG2);
            attn_compute(lds, qf, u, og, LSE + (size_t)u.g * MTOK * 8);
            asm volatile("s_waitcnt lgkmcnt(0)" ::: "memory"); __builtin_amdgcn_s_barrier(); asm volatile("" ::: "memory");
        }
    }
    xcd_barrier(xbar);
    {
        PHASE_IDS();
        constexpr int TB = 32;
        const size_t nitems = (size_t)(MTOK / TB) * 128;
        for (size_t it = gt; it < nitems; it += NGT) {
            const size_t tok0 = (it >> 7) * TB; const int ac = (int)(it & 127), h = ac >> 4, c0 = ac * 8;
#pragma unroll 4
            for (int t = 0; t < TB; ++t) {
                const size_t tok = tok0 + t;
                const float l0 = LSE[tok * 8 + h], l1 = LSE[(size_t)MTOK * 8 + tok * 8 + h], l2 = LSE[(size_t)2 * MTOK * 8 + tok * 8 + h];
                const float mm = fmaxf(l0, fmaxf(l1, l2));
                float w0 = __builtin_amdgcn_exp2f(l0 - mm), w1 = __builtin_amdgcn_exp2f(l1 - mm), w2 = __builtin_amdgcn_exp2f(l2 - mm);
                const float inv = 1.0f / (w0 + w1 + w2); w0 *= inv; w1 *= inv; w2 *= inv;
                const v4u a0 = *(const v4u*)(OG0 + tok * 1024 + c0), a1 = *(const v4u*)(OG1 + tok * 1024 + c0), a2 = *(const v4u*)(OG2 + tok * 1024 + c0);
                v4u o;
                o.x = cvtpk(w0 * bflo(a0.x) + w1 * bflo(a1.x) + w2 * bflo(a2.x), w0 * bfhi(a0.x) + w1 * bfhi(a1.x) + w2 * bfhi(a2.x));
                o.y = cvtpk(w0 * bflo(a0.y) + w1 * bflo(a1.y) + w2 * bflo(a2.y), w0 * bfhi(a0.y) + w1 * bfhi(a1.y) + w2 * bfhi(a2.y));
                o.z = cvtpk(w0 * bflo(a0.z) + w1 * bflo(a1.z) + w2 * bflo(a2.z), w0 * bfhi(a0.z) + w1 * bfhi(a1.z) + w2 * bfhi(a2.z));
                o.w = cvtpk(w0 * bflo(a0.w) + w1 * bflo(a1.w) + w2 * bflo(a2.w), w0 * bfhi(a0.w) + w1 * bfhi(a1.w) + w2 * bfhi(a2.w));
                *(v4u*)(YMIX + tok * DM + CONVW + c0) = o;
            }
        }
        const size_t nfix = (size_t)(MTOK / 256) * 2 * (CONVW / 4);
        for (size_t it = gt; it < nfix; it += NGT) {
            const int c = 4 * (int)(it % (CONVW / 4)); const int pk = (int)(it / (CONVW / 4)); const int k = pk & 1, pm = pk >> 1;
            if ((pm & 15) == 0) continue;
            const f32x4 cur = *(const f32x4*)(RAWC + ((size_t)pm * 4 + k) * 1024 + c);
            const f32x4 p1 = *(const f32x4*)(RAWC + (k == 0 ? ((size_t)(pm - 1) * 4 + 3) : ((size_t)pm * 4 + 0)) * 1024 + c);
            const f32x4 p2 = *(const f32x4*)(RAWC + ((size_t)(pm - 1) * 4 + (k == 0 ? 2 : 3)) * 1024 + c);
            const f32x4 gb = *(const f32x4*)(RAWB + ((size_t)pm * 2 + k) * 1024 + c);
            const f32x4 w0 = *(const f32x4*)(conv_mix_w + c), w1 = *(const f32x4*)(conv_mix_w + CONVW + c), w2 = *(const f32x4*)(conv_mix_w + 2 * CONVW + c);
            const f32x4 y = gb * (w2 * cur + w1 * p1 + w0 * p2);
            v2u wv; wv.x = cvtpk(y[0], y[1]); wv.y = cvtpk(y[2], y[3]);
            *(v2u*)(YMIX + ((size_t)pm * 256 + k) * DM + c) = wv;
        }
    }
    xcd_barrier(xbar);
    {
        pg8::Gemm g{YMIX, WOUT, MTOK, DM, DM}; pg8::StaticOrder S; S.init(MTOK, DM, G, bx);
        pg8::EpiBf16 E{MIXB, DM};
        pg8::gemm_phase<pg8::EpiBf16, pg8::StaticOrder, false, true>(lds, g, S, E);
    }
    xcd_barrier(xbar);
    { PHASE_IDS();
    for (int m = gw; m < MTOK; m += NGW) {
        float* row = HF + (size_t)m * DM; const float* xr = x + (size_t)m * DM; const bf16* mr = MIXB + (size_t)m * DM; f32x4 v[8]; float s = 0.f;
#pragma unroll
        for (int j = 0; j < 8; ++j) { const int c = 4 * (lane + 64 * j); const f32x4 xv = *(const f32x4*)(xr + c); const v2u mv = *(const v2u*)(mr + c);
            v[j] = xv * ALPHA + (f32x4){bflo(mv.x), bfhi(mv.x), bflo(mv.y), bfhi(mv.y)}; s += (v[j][0] + v[j][1]) + (v[j][2] + v[j][3]); }
        const float mean = wave_sum(s) * (1.f / DM); float s2 = 0.f;
#pragma unroll
        for (int j = 0; j < 8; ++j) { v[j] = v[j] - mean; s2 += (v[j][0] * v[j][0] + v[j][1] * v[j][1]) + (v[j][2] * v[j][2] + v[j][3] * v[j][3]); }
        const float rstd = 1.f / sqrtf(wave_sum(s2) * (1.f / DM) + LN_EPS);
#pragma unroll
        for (int j = 0; j < 8; ++j) { const int c = 4 * (lane + 64 * j); const f32x4 gg = *(const f32x4*)(ln1_g + c), bb = *(const f32x4*)(ln1_b + c);
            const f32x4 o = v[j] * rstd * gg + bb; *(f32x4*)(row + c) = o;
            v2u wv; wv.x = cvtpk(o[0], o[1]); wv.y = cvtpk(o[2], o[3]); *(v2u*)(HB + (size_t)m * DM + c) = wv; }
    } }
    xcd_barrier(xbar);
    {
        pg8::Gemm g{HB, WUP, MTOK, UPW, DM}; pg8::StaticOrder S; S.init(MTOK, UPW, G, bx);
        pg8::EpiFfn E{ACT, RAW, ffn_conv_w, ffn_conv_b, (LAS float*)(lds + LDS_XCH), DFF};
        pg8::gemm_phase<pg8::EpiFfn, pg8::StaticOrder, true, true>(lds, g, S, E);
    }
    xcd_barrier(xbar);
    {
        PHASE_IDS();
        const size_t nitems = (size_t)(MTOK / 256) * 2 * (DFF / 4);
        for (size_t it = gt; it < nitems; it += NGT) {
            const int c4 = (int)(it % (DFF / 4)); const int pk = (int)(it / (DFF / 4)); const int k = pk & 1, pm = pk >> 1;
            if ((pm & 15) == 0) continue;
            const int c = 4 * c4, col = (c >> 7) * 256 + (c & 127);
            const float* rc = RAW + ((size_t)pm * 4 + k) * UPW + col;
            const float* r1 = k == 0 ? RAW + ((size_t)(pm - 1) * 4 + 3) * UPW + col : RAW + ((size_t)pm * 4 + 0) * UPW + col;
            const float* r2 = k == 0 ? RAW + ((size_t)(pm - 1) * 4 + 2) * UPW + col : RAW + ((size_t)(pm - 1) * 4 + 3) * UPW + col;
            f32x4 v[2];
#pragma unroll
            for (int bj = 0; bj < 2; ++bj) {
                const f32x4 w0 = *(const f32x4*)(ffn_conv_w + bj * DFF + c), w1 = *(const f32x4*)(ffn_conv_w + UPW + bj * DFF + c), w2 = *(const f32x4*)(ffn_conv_w + 2 * UPW + bj * DFF + c), bb = *(const f32x4*)(ffn_conv_b + bj * DFF + c);
                v[bj] = w2 * *(const f32x4*)(rc + bj * 128) + w1 * *(const f32x4*)(r1 + bj * 128) + w0 * *(const f32x4*)(r2 + bj * 128) + bb;
            }
            float y[4];
#pragma unroll
            for (int jj = 0; jj < 4; ++jj) { const float gg = v[1][jj]; y[jj] = v[0][jj] * gg / (1.0f + __expf(-gg)); }
            v2u wv; wv.x = cvtpk(y[0], y[1]); wv.y = cvtpk(y[2], y[3]);
            *(v2u*)(ACT + ((size_t)pm * 256 + k) * DFF + c) = wv;
        }
    }
    xcd_barrier(xbar);
    {
        pg8::Gemm g{ACT, WDN, MTOK, DM, DFF}; pg8::StaticOrder S; S.init(MTOK, DM, G, bx);
        pg8::EpiBf16 E{MIXB, DM};
        pg8::gemm_phase<pg8::EpiBf16, pg8::StaticOrder, false, true>(lds, g, S, E);
    }
    xcd_barrier(xbar);
    { PHASE_IDS();
    for (int m = gw; m < MTOK; m += NGW) {
        const float* row = HF + (size_t)m * DM; const bf16* mr = MIXB + (size_t)m * DM; f32x4 v[8]; float s = 0.f;
#pragma unroll
        for (int j = 0; j < 8; ++j) { const int c = 4 * (lane + 64 * j); const f32x4 hv = *(const f32x4*)(row + c); const v2u mv = *(const v2u*)(mr + c);
            v[j] = hv * ALPHA + (f32x4){bflo(mv.x), bfhi(mv.x), bflo(mv.y), bfhi(mv.y)}; s += (v[j][0] + v[j][1]) + (v[j][2] + v[j][3]); }
        const float mean = wave_sum(s) * (1.f / DM); float s2 = 0.f;
#pragma unroll
        for (int j = 0; j < 8; ++j) { v[j] = v[j] - mean; s2 += (v[j][0] * v[j][0] + v[j][1] * v[j][1]) + (v[j][2] * v[j][2] + v[j][3] * v[j][3]); }
        const float rstd = 1.f / sqrtf(wave_sum(s2) * (1.f / DM) + LN_EPS);
#pragma unroll
        for (int j = 0; j < 8; ++j) { const int c = 4 * (lane + 64 * j); const f32x4 gg = *(const f32x4*)(ln2_g + c), bb = *(const f32x4*)(ln2_b + c);
            *(f32x4*)(args.out + (size_t)m * DM + c) = v[j] * rstd * gg + bb; }
    } }
}

extern "C" void kernel_launch(void* const* d_in, const int* in_sizes, int n_in, void* d_out, int out_size, void* d_ws, size_t ws_size, hipStream_t stream) {
    static int grid = 0;
    if (grid == 0) {
        if (n_in != 13 || in_sizes[0] != MTOK * DM || out_size != MTOK * DM || ws_size < WS_END) { fprintf(stderr, "kernel_launch: unexpected shapes (n_in %d, ws %zu)\n", n_in, ws_size); grid = -1; return; }
        int dev = 0, cus = 0, per_cu = 0;
        (void)hipGetDevice(&dev); (void)hipDeviceGetAttribute(&cus, hipDeviceAttributeMultiprocessorCount, dev);
        if (hipFuncSetAttribute((const void*)fwd_megakernel, hipFuncAttributeMaxDynamicSharedMemorySize, LDS_BYTES) != hipSuccess) { fprintf(stderr, "kernel_launch: hipFuncSetAttribute failed\n"); grid = -1; return; }
        if (hipOccupancyMaxActiveBlocksPerMultiprocessor(&per_cu, (const void*)fwd_megakernel, NTHREADS, LDS_BYTES) != hipSuccess || per_cu < 1) { fprintf(stderr, "kernel_launch: occupancy query gave %d\n", per_cu); per_cu = 1; }
        (void)hipGetLastError();
        grid = cus;
    }
    if (grid < 0) return;
    Args a{};
    for (int i = 0; i < 13; ++i) a.in[i] = (const float*)d_in[i];
    a.out = (float*)d_out; a.ws = (unsigned char*)d_ws;
    void* kargs[] = {&a};
    hipError_t e = hipLaunchCooperativeKernel((const void*)fwd_megakernel, dim3(grid), dim3(NTHREADS), kargs, LDS_BYTES, stream);
    if (e != hipSuccess) fprintf(stderr, "kernel_launch: cooperative launch failed: %s (grid %d)\n", hipGetErrorString(e), grid);
}
```
